# Optimizing an MI355X kernel written in HIP

```python
import jax, jax.numpy as jnp
from jax import lax
import numpy as np

D_MODEL = 1024
BATCH = 8
SEQ = 4096
DEPTH = 4

GRID_W = 64
CTX_LEN = 256
MIX_WIDTH = D_MODEL
POOL_WIDTH = MIX_WIDTH // 2
N_POOL_GROUPS = 4
POOL_GROUP_DIM = POOL_WIDTH // N_POOL_GROUPS
POOL_WINDOWS = (2, 4, 8, 16)
ATTN_WIDTH = MIX_WIDTH - POOL_WIDTH
N_HEADS = 8
HEAD_DIM = ATTN_WIDTH // N_HEADS
NA_KH = 8
NA_KW = 16
NA_QB = 16
NA_KB = 32
NA_NCB = GRID_W // NA_QB
D_FF = 4 * D_MODEL
N_MOD = 6
EPS = 1e-6

kernel_name = 'hybrid_pool_natten_dit_block'


def _rmsnorm(x, g):
    x32 = x.astype(jnp.float32)
    y = x32 * lax.rsqrt(jnp.mean(x32 * x32, axis=-1, keepdims=True) + EPS)
    return (y * g.astype(jnp.float32)).astype(x.dtype)


def _modulate(x, gain, shift, scale):
    return _rmsnorm(x, gain) * (1 + scale) + shift


def _project(h, w_in_l):
    p = h @ w_in_l
    B, L, _ = p.shape
    u = p[..., :POOL_WIDTH]
    q, k, v = jnp.split(p[..., POOL_WIDTH:], 3, axis=-1)
    shp = (B, L, N_HEADS, HEAD_DIM)
    return u, q.reshape(shp), k.reshape(shp), v.reshape(shp)


def _pool_mixer(u, pool_w, pool_scale):
    B, L, _ = u.shape
    u32 = u.reshape(B, L, N_POOL_GROUPS, POOL_GROUP_DIM).astype(jnp.float32)
    cs = jnp.concatenate([jnp.zeros_like(u32[:, :1]), jnp.cumsum(u32, axis=1)], axis=1)
    t = jnp.arange(L)
    diffs = []
    for g, w in enumerate(POOL_WINDOWS):
        lo = w // 2
        hi = w - 1 - lo
        start = jnp.clip(t - lo, 0, L)
        end = jnp.clip(t + hi + 1, 0, L)
        count = (end - start).astype(jnp.float32)[None, :, None]
        diffs.append((cs[:, end, g] - cs[:, start, g]) / count - u32[:, :, g])
    d = jnp.stack(diffs, axis=2).astype(u.dtype)
    y = jnp.einsum('blgc,gcd->blgd', d, pool_w)
    return y.reshape(B, L, POOL_WIDTH) * pool_scale


def _na_column_tables():
    qcol = np.arange(GRID_W).reshape(NA_NCB, NA_QB)
    q_start = np.clip(qcol - NA_KW // 2, 0, GRID_W - NA_KW)
    kc0 = np.clip(np.arange(NA_NCB) * NA_QB - NA_KW // 2, 0, GRID_W - NA_KB)
    col_idx = kc0[:, None] + np.arange(NA_KB)
    kc = col_idx[:, None, :]
    mask = (kc >= q_start[:, :, None]) & (kc < q_start[:, :, None] + NA_KW)
    dc = np.clip(kc - qcol[:, :, None] + NA_KW - 1, 0, 2 * NA_KW - 2)
    return col_idx.astype(np.int32), mask, dc.astype(np.int32)


def _neighbourhood_attention(q, k, v, k_ctx, v_ctx, rpb):
    B, L, H, Dh = q.shape
    rows = L // GRID_W
    kh = min(NA_KH, rows)
    col_np, mask_np, dc_np = _na_column_tables()
    col_idx = jnp.asarray(col_np)
    col_mask = jnp.asarray(mask_np)[:, :, None, :]
    dc_idx = jnp.asarray(dc_np)[:, :, None, :]
    qg = q.reshape(B, rows, GRID_W, H, Dh)
    kg = k.reshape(B, rows, GRID_W, H, Dh)
    vg = v.reshape(B, rows, GRID_W, H, Dh)
    scale = Dh ** -0.5
    n_loc = kh * NA_KB

    def row_block(r):
        rs = jnp.clip(r - kh // 2, 0, rows - kh)
        q_r = lax.dynamic_index_in_dim(qg, r, axis=1, keepdims=False).reshape(B, NA_NCB, NA_QB, H, Dh)
        k_b = lax.dynamic_slice_in_dim(kg, rs, kh, axis=1)[:, :, col_idx]
        v_b = lax.dynamic_slice_in_dim(vg, rs, kh, axis=1)[:, :, col_idx]
        s_loc = jnp.einsum('bnqhd,brnkhd->bhnqrk', q_r, k_b).astype(jnp.float32) * scale
        dr_idx = rs + jnp.arange(kh) - r + (NA_KH - 1)
        bias = rpb[:, dr_idx[None, None, :, None], dc_idx]
        s_loc = jnp.where(col_mask, s_loc + bias.astype(jnp.float32), -jnp.inf)
        s_ctx = jnp.einsum('bnqhd,bkhd->bhnqk', q_r, k_ctx).astype(jnp.float32) * scale
        s = jnp.concatenate([s_loc.reshape(B, H, NA_NCB, NA_QB, n_loc), s_ctx], axis=-1)
        p = jax.nn.softmax(s, axis=-1).astype(v.dtype)
        p_loc = p[..., :n_loc].reshape(B, H, NA_NCB, NA_QB, kh, NA_KB)
        p_ctx = p[..., n_loc:]
        o = (jnp.einsum('bhnqrk,brnkhd->bnqhd', p_loc, v_b)
             + jnp.einsum('bhnqk,bkhd->bnqhd', p_ctx, v_ctx))
        return o.reshape(B, GRID_W, H, Dh)

    out = lax.map(row_block, jnp.arange(rows))
    return jnp.moveaxis(out, 0, 1).reshape(B, L, H * Dh)


def _context_attention(q, k, v):
    B, C, H, Dh = q.shape
    s = jnp.einsum('bqhd,bkhd->bhqk', q, k).astype(jnp.float32) * (Dh ** -0.5)
    p = jax.nn.softmax(s, axis=-1).astype(v.dtype)
    return jnp.einsum('bhqk,bkhd->bqhd', p, v).reshape(B, C, H * Dh)


def _sq_relu_mlp(h, w1, w2):
    return jnp.square(jax.nn.relu(h @ w1)) @ w2


def setup_inputs(seed: int = 0) -> dict:
    key = jax.random.key(seed)
    ks = jax.random.split(key, 17)
    D = D_MODEL
    nrm = jax.random.normal
    return {
        'x': nrm(ks[0], (BATCH, SEQ, D), jnp.float32),
        'c': nrm(ks[1], (BATCH, D), jnp.float32),
        'ctx': nrm(ks[2], (BATCH, CTX_LEN, D), jnp.float32),
        'c_ctx': nrm(ks[3], (D,), jnp.float32),
        'w_mod': nrm(ks[4], (DEPTH, D, N_MOD * D), jnp.float32) * (0.5 * D ** -0.5),
        'b_mod': nrm(ks[5], (DEPTH, N_MOD * D), jnp.float32) * 0.02,
        'g_pre_mix': 1.0 + 0.1 * nrm(ks[6], (DEPTH, D), jnp.float32),
        'g_post_mix': 1.0 + 0.1 * nrm(ks[7], (DEPTH, D), jnp.float32),
        'g_pre_mlp': 1.0 + 0.1 * nrm(ks[8], (DEPTH, D), jnp.float32),
        'g_post_mlp': 1.0 + 0.1 * nrm(ks[9], (DEPTH, D), jnp.float32),
        'w_in': nrm(ks[10], (DEPTH, D, POOL_WIDTH + 3 * ATTN_WIDTH), jnp.float32) * D ** -0.5,
        'pool_w': nrm(ks[11], (DEPTH, N_POOL_GROUPS, POOL_GROUP_DIM, POOL_GROUP_DIM), jnp.float32) * POOL_GROUP_DIM ** -0.5,
        'pool_scale': 1.0 + 0.1 * nrm(ks[12], (DEPTH, POOL_WIDTH), jnp.float32),
        'rpb': 0.1 * nrm(ks[13], (DEPTH, N_HEADS, 2 * NA_KH - 1, 2 * NA_KW - 1), jnp.float32),
        'w_out': nrm(ks[14], (DEPTH, MIX_WIDTH, D), jnp.float32) * MIX_WIDTH ** -0.5,
        'w_mlp_in': nrm(ks[15], (DEPTH, D, D_FF), jnp.float32) * D ** -0.5,
        'w_mlp_out': nrm(ks[16], (DEPTH, D_FF, D), jnp.float32) * D_FF ** -0.5,
    }


def reference(x, c, ctx, c_ctx, w_mod, b_mod, g_pre_mix, g_post_mix, g_pre_mlp, g_post_mlp,
              w_in, pool_w, pool_scale, rpb, w_out, w_mlp_in, w_mlp_out):
    for l in range(DEPTH):
        last = l == DEPTH - 1
        mod_x = (jax.nn.silu(c) @ w_mod[l] + b_mod[l])[:, None, :]
        mod_c = jax.nn.silu(c_ctx) @ w_mod[l] + b_mod[l]
        sh1, sc1, gt1, sh2, sc2, gt2 = jnp.split(mod_x, N_MOD, axis=-1)
        csh1, csc1, cgt1, csh2, csc2, cgt2 = jnp.split(mod_c, N_MOD, axis=-1)

        h_x = _modulate(x, g_pre_mix[l], sh1, sc1)
        h_c = _modulate(ctx, g_pre_mix[l], csh1, csc1)
        u_x, q_x, k_x, v_x = _project(h_x, w_in[l])
        u_c, q_c, k_c, v_c = _project(h_c, w_in[l])
        attn_x = _neighbourhood_attention(q_x, k_x, v_x, k_c, v_c, rpb[l])
        mix_x = jnp.concatenate([_pool_mixer(u_x, pool_w[l], pool_scale[l]), attn_x], axis=-1) @ w_out[l]
        x = x + gt1 * _rmsnorm(mix_x, g_post_mix[l])
        y_x = _sq_relu_mlp(_modulate(x, g_pre_mlp[l], sh2, sc2), w_mlp_in[l], w_mlp_out[l])
        x = x + gt2 * _rmsnorm(y_x, g_post_mlp[l])

        if not last:
            attn_c = _context_attention(q_c, k_c, v_c)
            mix_c = jnp.concatenate([_pool_mixer(u_c, pool_w[l], pool_scale[l]), attn_c], axis=-1) @ w_out[l]
            ctx = ctx + cgt1 * _rmsnorm(mix_c, g_post_mix[l])
            y_c = _sq_relu_mlp(_modulate(ctx, g_pre_mlp[l], csh2, csc2), w_mlp_in[l], w_mlp_out[l])
            ctx = ctx + cgt2 * _rmsnorm(y_c, g_post_mlp[l])
    return x
```

```cpp
#include <hip/hip_runtime.h>
#include <hip/hip_cooperative_groups.h>
#include <cstdio>
#include <cstdint>
namespace cg = cooperative_groups;

#ifndef MK_SPLIT
#define MK_SPLIT 1
#endif

#define LAS __attribute__((address_space(3)))
typedef unsigned short bf16_t;
typedef short bf16x8 __attribute__((ext_vector_type(8)));
typedef float f32x4 __attribute__((ext_vector_type(4)));
typedef float f32x2 __attribute__((ext_vector_type(2)));
typedef unsigned u32x4 __attribute__((ext_vector_type(4)));
typedef unsigned u32x2 __attribute__((ext_vector_type(2)));

constexpr int DM = 1024, NB = 8, SEQ = 4096, CT = 256, DEPTH = 4, FF = 4096, NIN = 2048;
constexpr int ML = NB * SEQ, MC = NB * CT, MT = ML + MC;
constexpr int NMOD = 6 * DM;
constexpr int PBW = 1536;
constexpr float EPS = 1e-6f;
constexpr int NWAVES = 8, NTHR = 512;

constexpr size_t MiB = 1u << 20;
constexpr size_t WS_MOD = 0;
constexpr size_t WS_SS = 1 * MiB;
constexpr size_t WS_CTXR = 4 * MiB;
constexpr size_t WS_WIN = 12 * MiB;
constexpr size_t WS_WOUT = 28 * MiB;
constexpr size_t WS_W1 = 36 * MiB;
constexpr size_t WS_W2 = 68 * MiB;
constexpr size_t WS_XN = 100 * MiB;
constexpr size_t WS_H = 168 * MiB;
constexpr size_t WS_PB = WS_H;
constexpr size_t WS_VT = 270 * MiB;
constexpr size_t WS_MIX = 304 * MiB;
constexpr size_t WS_END = 440 * MiB;
static_assert(WS_PB + (size_t)MT * PBW * 2 <= WS_VT && WS_VT + (size_t)512 * MT * 2 <= WS_MIX && WS_MIX + (size_t)MT * DM * 2 <= WS_END, "ws");
static_assert(WS_H + (size_t)MT * FF * 2 <= WS_END, "ws h");

constexpr int LDS_BYTES = 147456;

__device__ __forceinline__ unsigned cvt_pk_bf16(float lo, float hi) { unsigned r; asm volatile("v_cvt_pk_bf16_f32 %0, %1, %2" : "=v"(r) : "v"(lo), "v"(hi)); return r; }
__device__ __forceinline__ float bf_lo(unsigned w) { return __uint_as_float(w << 16); }
__device__ __forceinline__ float bf_hi(unsigned w) { return __uint_as_float(w & 0xffff0000u); }
__device__ __forceinline__ float wave_sum(float v) {
#pragma unroll
    for (int o = 1; o < 64; o <<= 1) v += __shfl_xor(v, o);
    return v;
}
#define LDS_WAIT() asm volatile("s_waitcnt lgkmcnt(0)" ::: "memory")

namespace pg8 {
constexpr int BM = 256, BK = 64, HALF = 128, HTB = HALF * BK * 2, STAGE_BYTES = 8 * HTB, NXCD = 8, WGM = 8;
__host__ __device__ __forceinline__ int lds_byte(int r, int c) { const int st = (r >> 4) * 2 + (c >> 5), rr = r & 15, cc = c & 31, ob = rr * 64 + cc * 2; return st * 1024 + (ob ^ (((ob >> 9) & 1) << 5)); }
__host__ __device__ __forceinline__ void stage_rc(int b, int& R, int& C) { const int st = b / 1024, sb = b % 1024, swz = sb ^ (((sb >> 9) & 1) << 5); R = (st >> 1) * 16 + swz / 64; C = (st & 1) * 32 + (swz % 64) / 2; }
__host__ __device__ __forceinline__ int perm32(int rho) { const int n = rho >> 4, i = rho & 15; return 8 * (i >> 2) + 4 * n + (i & 3); }

struct Unit { int pm, pn; };
struct Gemm { const bf16_t* A; const bf16_t* Bt; int K; int nN_main; };

struct StaticOrder {
    int nM, nN, nwg, G, c;
    __device__ void init(int nM_, int nN_, int G_, int c_) { nM = nM_; nN = nN_; nwg = nM * nN; G = G_; c = c_; }
    __device__ bool next(int i, Unit& u) const {
        const long L = (long)i * G + c; if (L >= nwg) return false;
        int wgid = (int)L; { const int q = nwg / NXCD, r = nwg % NXCD, xcd = wgid % NXCD, off = wgid / NXCD; wgid = (xcd < r ? xcd * (q + 1) : r * (q + 1) + (xcd - r) * q) + off; }
        const int nig = WGM * nN, gid = wgid / nig, fm = gid * WGM, gsz = (nM - fm) < WGM ? (nM - fm) : WGM;
        u.pm = fm + ((wgid % nig) % gsz); u.pn = (wgid % nig) / gsz; return true;
    }
};

template <int MODE> struct Epi {
    bf16_t* O; bf16_t* O2; float* ss;
    __device__ __forceinline__ void operator()(const f32x4 (&acc)[2][2][4][2], const Unit& u, int wr, int wc, int fr, int fq) const {
        int prow = u.pm, pcol = u.pn; bf16_t* base = O; size_t ldc = (MODE == 0) ? PBW : (MODE == 1 ? DM : FF);
        if (MODE == 0 && u.pn >= 6) { prow = u.pn - 6; pcol = u.pm; base = O2; ldc = MT; }
        const int row0 = prow * BM + wr * 64 + fr, col0 = pcol * BM + wc * 32 + 8 * fq;
#pragma unroll
        for (int ai = 0; ai < 2; ++ai)
#pragma unroll
            for (int m = 0; m < 4; ++m) { bf16_t* rowp = base + (size_t)(row0 + ai * HALF + m * 16) * ldc + col0; float sq = 0.f;
#pragma unroll
                for (int bj = 0; bj < 2; ++bj) { f32x4 v0 = acc[ai][bj][m][0], v1 = acc[ai][bj][m][1];
                    if (MODE == 2) {
#pragma unroll
                        for (int e = 0; e < 4; ++e) { const float a = fmaxf(v0[e], 0.f), b = fmaxf(v1[e], 0.f); v0[e] = a * a; v1[e] = b * b; } }
                    if (MODE == 1) sq += (v0[0] * v0[0] + v0[1] * v0[1]) + (v0[2] * v0[2] + v0[3] * v0[3]) + (v1[0] * v1[0] + v1[1] * v1[1]) + (v1[2] * v1[2] + v1[3] * v1[3]);
                    u32x4 w; w.x = cvt_pk_bf16(v0[0], v0[1]); w.y = cvt_pk_bf16(v0[2], v0[3]); w.z = cvt_pk_bf16(v1[0], v1[1]); w.w = cvt_pk_bf16(v1[2], v1[3]);
                    *(u32x4*)(rowp + bj * HALF) = w; }
                if (MODE == 1) { sq += __shfl_xor(sq, 16); sq += __shfl_xor(sq, 32);
                    if (fq == 0) ss[(size_t)(row0 + ai * HALF + m * 16) * 16 + u.pn * 4 + wc] = sq; } }
    }
};

template <class EpiT, bool ALIGN_EPI>
__device__ __forceinline__ void gemm_phase(LAS unsigned char* lds, const Gemm g, const StaticOrder& S, const EpiT& E, const int tid) {
    const int wid = __builtin_amdgcn_readfirstlane(tid >> 6), lane = tid & 63, wr = wid >> 2, wc = wid & 3, fr = lane & 15, fq = lane >> 4;
    const int K = g.K, nt = K / BK;
    unsigned voffA[2], voffB[2];
#pragma unroll
    for (int i = 0; i < 2; ++i) { int R, C; stage_rc(tid * 16 + i * 8192, R, C); const int Rb = (R & ~31) + perm32(R & 31);
        voffA[i] = (unsigned)(R * K + C) * 2u; voffB[i] = (unsigned)(Rb * K + C) * 2u; }
    const size_t kstep = (size_t)(BK * 2);
    const size_t hstep = (size_t)HALF * K * 2;
    const size_t tstep = 2 * hstep;
    const unsigned ldsw = (unsigned)wid * 1024u;
    const int aoff = lds_byte(wr * 64 + fr, fq * 8), boff = lds_byte(wc * 32 + fr, fq * 8);
#define PG8_SA(b, h) (((b) * 2 + (h)) * HTB)
#define PG8_SB(b, h) ((4 + (b) * 2 + (h)) * HTB)
#define PG8_STAGE(bufoff, gbase, voff) do { _Pragma("unroll") for (int _i = 0; _i < 2; ++_i) \
        __builtin_amdgcn_global_load_lds((const unsigned*)((const char*)(gbase) + (voff)[_i]), (LAS unsigned*)(lds + (bufoff) + ldsw + _i * 8192), 16, 0, 0); } while (0)
#define PG8_LDA(dst, b, h) do { _Pragma("unroll") for (int m = 0; m < 4; ++m) _Pragma("unroll") for (int k = 0; k < 2; ++k) dst[m][k] = *(const LAS bf16x8*)(lds + PG8_SA(b, h) + aoff + m * 2048 + k * 1024); } while (0)
#define PG8_LDB(dst, b, h) do { _Pragma("unroll") for (int n = 0; n < 2; ++n) _Pragma("unroll") for (int k = 0; k < 2; ++k) dst[n][k] = *(const LAS bf16x8*)(lds + PG8_SB(b, h) + boff + n * 2048 + k * 1024); } while (0)
#define PG8_MMA(ai, bj, At, Bt) do { __builtin_amdgcn_s_setprio(1); _Pragma("unroll") for (int m = 0; m < 4; ++m) _Pragma("unroll") for (int n = 0; n < 2; ++n) _Pragma("unroll") for (int k = 0; k < 2; ++k) \
        acc[ai][bj][m][n] = __builtin_amdgcn_mfma_f32_16x16x32_bf16(Bt[n][k], At[m][k], acc[ai][bj][m][n], 0, 0, 0); __builtin_amdgcn_s_setprio(0); } while (0)
#define PG8_WAIT_V(n) asm volatile("s_waitcnt vmcnt(" #n ")" ::: "memory")
#define PG8_WAIT_L(n) asm volatile("s_waitcnt lgkmcnt(" #n ")" ::: "memory")
#define PG8_BAR __builtin_amdgcn_s_barrier()
#define PG8_SCHED __builtin_amdgcn_sched_barrier(0)
#define PG8_PTRS(u, pa, pb) do { const char* _a = (const char*)g.A + (size_t)(u).pm * tstep; const char* _b = (const char*)g.Bt + (size_t)(u).pn * tstep; \
        if ((u).pn >= g.nN_main) { pa = _b; pb = _a; } else { pa = _a; pb = _b; } } while (0)
    Unit cur, nxt; int ui = 0;
    if (!S.next(0, cur)) return;
    f32x4 acc[2][2][4][2];
#pragma unroll
    for (int a = 0; a < 2; ++a)
#pragma unroll
        for (int b = 0; b < 2; ++b)
#pragma unroll
            for (int m = 0; m < 4; ++m)
#pragma unroll
                for (int n = 0; n < 2; ++n) acc[a][b][m][n] = (f32x4){0.f, 0.f, 0.f, 0.f};
    bf16x8 At[4][2], B0[2][2], B1[2][2];
    const char* cA; const char* cB; PG8_PTRS(cur, cA, cB);
    PG8_STAGE(PG8_SB(0, 0), cB, voffB); PG8_STAGE(PG8_SB(0, 1), cB + hstep, voffB); PG8_STAGE(PG8_SA(0, 0), cA, voffA); PG8_STAGE(PG8_SA(0, 1), cA + hstep, voffA);
    if (wr == 1) PG8_BAR;
    PG8_WAIT_V(2); PG8_BAR;
    PG8_STAGE(PG8_SB(1, 0), cB + kstep, voffB); PG8_STAGE(PG8_SA(1, 0), cA + kstep, voffA); PG8_STAGE(PG8_SB(1, 1), cB + hstep + kstep, voffB);
    PG8_WAIT_V(6); PG8_BAR;
    for (;;) {
        const bool has_next = S.next(ui + 1, nxt);
        const char* nA = cA; const char* nB = cB; if (has_next) PG8_PTRS(nxt, nA, nB);
        for (int t = 0; t < nt; t += 2) {
            const bool last = (t == nt - 2);
            const char* a1 = cA + (size_t)(t + 1) * kstep;
            const char* a2 = last ? nA : cA + (size_t)(t + 2) * kstep; const char* b2 = last ? nB : cB + (size_t)(t + 2) * kstep;
            const char* a3 = a2 + kstep; const char* b3 = b2 + kstep;
            PG8_LDB(B0, 0, 0); PG8_LDB(B1, 0, 1); PG8_SCHED; PG8_LDA(At, 0, 0); PG8_STAGE(PG8_SA(1, 1), a1 + hstep, voffA);
            PG8_WAIT_V(8); PG8_WAIT_L(0); PG8_BAR; PG8_MMA(0, 0, At, B0); PG8_MMA(0, 1, At, B1); PG8_BAR; PG8_SCHED;
            PG8_LDA(At, 0, 1); PG8_STAGE(PG8_SB(0, 0), b2, voffB); PG8_STAGE(PG8_SB(0, 1), b2 + hstep, voffB); PG8_STAGE(PG8_SA(0, 0), a2, voffA);
            PG8_WAIT_V(8); PG8_WAIT_L(0); PG8_BAR; PG8_MMA(1, 0, At, B0); PG8_MMA(1, 1, At, B1); PG8_BAR; PG8_SCHED;
            PG8_LDB(B0, 1, 0); PG8_LDB(B1, 1, 1); PG8_SCHED; PG8_LDA(At, 1, 0); PG8_STAGE(PG8_SA(0, 1), a2 + hstep, voffA);
            PG8_WAIT_V(8); PG8_WAIT_L(0); PG8_BAR; PG8_MMA(0, 0, At, B0); PG8_MMA(0, 1, At, B1); PG8_BAR; PG8_SCHED;
            PG8_LDA(At, 1, 1); PG8_STAGE(PG8_SB(1, 0), b3, voffB); PG8_STAGE(PG8_SB(1, 1), b3 + hstep, voffB); PG8_STAGE(PG8_SA(1, 0), a3, voffA);
            PG8_WAIT_V(8); PG8_WAIT_L(0); PG8_BAR; PG8_MMA(1, 0, At, B0); PG8_MMA(1, 1, At, B1); PG8_BAR; PG8_SCHED;
        }
        if constexpr (ALIGN_EPI) { if (wr == 0) PG8_BAR; }
        E(acc, cur, wr, wc, fr, fq);
        if (!has_next) break;
#pragma unroll
        for (int a = 0; a < 2; ++a)
#pragma unroll
            for (int b = 0; b < 2; ++b)
#pragma unroll
                for (int m = 0; m < 4; ++m)
#pragma unroll
                    for (int n = 0; n < 2; ++n) acc[a][b][m][n] = (f32x4){0.f, 0.f, 0.f, 0.f};
        cur = nxt; cA = nA; cB = nB; ++ui;
        if constexpr (ALIGN_EPI) { if (wr == 1) PG8_BAR; }
    }
    PG8_WAIT_V(0);
    if constexpr (!ALIGN_EPI) { if (wr == 0) PG8_BAR; }
    PG8_BAR;
#undef PG8_SA
#undef PG8_SB
#undef PG8_STAGE
#undef PG8_LDA
#undef PG8_LDB
#undef PG8_MMA
#undef PG8_WAIT_V
#undef PG8_WAIT_L
#undef PG8_BAR
#undef PG8_SCHED
#undef PG8_PTRS
}
}

struct Params {
    const float* in[17];
    float* out; unsigned char* ws;
    int ph_lo, ph_hi;
};
enum { I_X = 0, I_C, I_CTX, I_CCTX, I_WMOD, I_BMOD, I_GPREMIX, I_GPOSTMIX, I_GPREMLP, I_GPOSTMLP, I_WIN, I_POOLW, I_POOLS, I_RPB, I_WOUT, I_W1, I_W2 };

__device__ __forceinline__ void transpose_item(const float* W, int ldw, bf16_t* WT, int ldt, int kofs, int nblk, LAS float* scr, int item, int lane) {
    const int kb = item / nblk, nb = item % nblk, k0 = 64 * kb, n0 = 32 * nb;
#pragma unroll 8
    for (int i = 0; i < 32; ++i) { const int kk = 2 * i + (lane >> 5); scr[kk * 33 + (lane & 31)] = W[(size_t)(k0 + kk) * ldw + n0 + (lane & 31)]; }
    LDS_WAIT(); asm volatile("" ::: "memory");
    const int c = lane & 7;
#pragma unroll
    for (int j = 0; j < 4; ++j) { const int n = (lane >> 3) + 8 * j; const LAS float* s = scr + (8 * c) * 33 + n;
        u32x4 o; o.x = cvt_pk_bf16(s[0 * 33], s[1 * 33]); o.y = cvt_pk_bf16(s[2 * 33], s[3 * 33]); o.z = cvt_pk_bf16(s[4 * 33], s[5 * 33]); o.w = cvt_pk_bf16(s[6 * 33], s[7 * 33]);
        *(u32x4*)(WT + (size_t)(n0 + n) * ldt + kofs + k0 + 8 * c) = o; }
    LDS_WAIT(); asm volatile("" ::: "memory");
}

__device__ __forceinline__ float silu_f(float v) { return v / (1.f + __expf(-v)); }

__device__ __forceinline__ void mod_item(const Params& p, LAS unsigned char* lds, int item, int tid, int wave, int lane) {
    LAS float* sv = (LAS float*)lds;
    LAS float* part = (LAS float*)(lds + 36864);
    const int l = item / 24, j0 = (item % 24) * 256;
    for (int i = tid; i < 9 * 1024; i += NTHR) { const int r = i >> 10, k = i & 1023; const float v = (r < 8) ? p.in[I_C][r * 1024 + k] : p.in[I_CCTX][k]; sv[i] = silu_f(v); }
    __syncthreads();
    f32x4 acc[9];
#pragma unroll
    for (int r = 0; r < 9; ++r) acc[r] = (f32x4){0.f, 0.f, 0.f, 0.f};
    const float* wp = p.in[I_WMOD] + (size_t)l * DM * NMOD + (size_t)(wave * 128) * NMOD + j0 + 4 * lane;
#pragma unroll 1
    for (int k8 = 0; k8 < 128; k8 += 8) {
        f32x4 wv[8];
#pragma unroll
        for (int u = 0; u < 8; ++u) wv[u] = *(const f32x4*)(wp + (size_t)(k8 + u) * NMOD);
#pragma unroll
        for (int u = 0; u < 8; ++u)
#pragma unroll
            for (int r = 0; r < 9; ++r) { const float s = sv[r * 1024 + wave * 128 + k8 + u]; acc[r] += wv[u] * s; }
    }
#pragma unroll
    for (int r = 0; r < 9; ++r) *(LAS f32x4*)(part + (wave * 9 + r) * 256 + 4 * lane) = acc[r];
    __syncthreads();
    float* mod = (float*)(p.ws + WS_MOD) + (size_t)l * 9 * NMOD;
    for (int i = tid; i < 9 * 256; i += NTHR) { const int r = i >> 8, j = i & 255; float s = p.in[I_BMOD][l * NMOD + j0 + j];
#pragma unroll
        for (int w = 0; w < 8; ++w) s += part[(w * 9 + r) * 256 + j];
        mod[r * NMOD + j0 + j] = s; }
    __syncthreads();
}

__device__ __forceinline__ void weff_item(const Params& p, LAS unsigned char* lds, int item, int tid, int wave, int lane) {
    LAS float* pw = (LAS float*)lds;
    LAS float* wo = (LAS float*)(lds + 128 * 129 * 4);
    const int l = item >> 6, g = (item >> 4) & 3, n0 = (item & 15) * 64;
    const float* pwg = p.in[I_POOLW] + ((size_t)l * 4 + g) * 128 * 128;
    for (int i = tid; i < 128 * 128; i += NTHR) pw[(i >> 7) * 129 + (i & 127)] = pwg[i];
    const float* wog = p.in[I_WOUT] + (size_t)l * DM * DM + (size_t)(g * 128) * DM + n0;
    const float* psg = p.in[I_POOLS] + l * 512 + g * 128;
    for (int i = tid; i < 128 * 64; i += NTHR) { const int d = i >> 6, n = i & 63; wo[i] = wog[(size_t)d * DM + n] * psg[d]; }
    __syncthreads();
    float acc[16];
#pragma unroll
    for (int c = 0; c < 16; ++c) acc[c] = 0.f;
    const int n = lane, cb = wave * 16;
#pragma unroll 4
    for (int d = 0; d < 128; ++d) { const float w = wo[d * 64 + n];
#pragma unroll
        for (int c = 0; c < 16; ++c) acc[c] += pw[(cb + c) * 129 + d] * w; }
    bf16_t* dst = (bf16_t*)(p.ws + WS_WOUT) + (size_t)l * DM * DM + (size_t)(n0 + n) * DM + g * 128 + cb;
    u32x4 o0, o1;
    o0.x = cvt_pk_bf16(acc[0], acc[1]); o0.y = cvt_pk_bf16(acc[2], acc[3]); o0.z = cvt_pk_bf16(acc[4], acc[5]); o0.w = cvt_pk_bf16(acc[6], acc[7]);
    o1.x = cvt_pk_bf16(acc[8], acc[9]); o1.y = cvt_pk_bf16(acc[10], acc[11]); o1.z = cvt_pk_bf16(acc[12], acc[13]); o1.w = cvt_pk_bf16(acc[14], acc[15]);
    *(u32x4*)dst = o0; *(u32x4*)(dst + 8) = o1;
    __syncthreads();
}

__device__ __forceinline__ void phase_prologue(const Params& p, LAS unsigned char* lds, int G, int tid, int wave, int lane) {
    for (int it = blockIdx.x; it < DEPTH * 24; it += G) mod_item(p, lds, it, tid, wave, lane);
    for (int it = blockIdx.x; it < DEPTH * 64; it += G) weff_item(p, lds, it, tid, wave, lane);
    LAS float* scr = (LAS float*)(lds + wave * 16384);
    const int gw = blockIdx.x * NWAVES + wave, NGW = G * NWAVES;
    constexpr int I_IN = 16 * 64, I_O = 8 * 32, I_1 = 16 * 128, I_2 = 64 * 32, I_L = I_IN + I_O + I_1 + I_2;
    for (int it = gw; it < DEPTH * I_L; it += NGW) {
        const int l = it / I_L; int r = it % I_L;
        if (r < I_IN) { transpose_item(p.in[I_WIN] + (size_t)l * DM * NIN, NIN, (bf16_t*)(p.ws + WS_WIN) + (size_t)l * NIN * DM, DM, 0, NIN / 32, scr, r, lane); continue; } r -= I_IN;
        if (r < I_O) { transpose_item(p.in[I_WOUT] + (size_t)l * DM * DM + (size_t)512 * DM, DM, (bf16_t*)(p.ws + WS_WOUT) + (size_t)l * DM * DM, DM, 512, DM / 32, scr, r, lane); continue; } r -= I_O;
        if (r < I_1) { transpose_item(p.in[I_W1] + (size_t)l * DM * FF, FF, (bf16_t*)(p.ws + WS_W1) + (size_t)l * FF * DM, DM, 0, FF / 32, scr, r, lane); continue; } r -= I_1;
        transpose_item(p.in[I_W2] + (size_t)l * FF * DM, DM, (bf16_t*)(p.ws + WS_W2) + (size_t)l * DM * FF, FF, 0, DM / 32, scr, r, lane);
    }
}

struct RowArgs {
    const float* xlat; const float* xctx;
    float* olat; float* octx;
    const float* gpost; const float* mod_cur;
    int gate_off;
    const float* gpre; const float* mod_nxt; int sh_off, sc_off;
    int nrows; bool has_y, write_xn;
};
__device__ __forceinline__ void phase_rows(const Params& p, const RowArgs& a, int G, int wave, int lane) {
    bf16_t* XN = (bf16_t*)(p.ws + WS_XN); const float* ss = (const float*)(p.ws + WS_SS);
    const int gw = blockIdx.x * NWAVES + wave, NGW = G * NWAVES;
    for (int m = gw; m < a.nrows; m += NGW) {
        const bool isl = m < ML; const int rb = isl ? (m >> 12) : 8;
        const float* xr = isl ? a.xlat + (size_t)m * DM : a.xctx + (size_t)(m - ML) * DM;
        f32x4 v[4];
#pragma unroll
        for (int j = 0; j < 4; ++j) v[j] = *(const f32x4*)(xr + 4 * lane + 256 * j);
        if (a.has_y) {
            float sp = (lane < 16) ? ss[(size_t)m * 16 + lane] : 0.f;
            const float rstd = rsqrtf(wave_sum(sp) * (1.f / DM) + EPS);
            const float* gt = a.mod_cur + (size_t)rb * NMOD + a.gate_off;
            float* xo = isl ? a.olat + (size_t)m * DM : a.octx + (size_t)(m - ML) * DM;
#pragma unroll
            for (int j = 0; j < 4; ++j) { const int c = 4 * lane + 256 * j;
                const u32x2 yw = *(const u32x2*)(XN + (size_t)m * DM + c);
                const f32x4 gp = *(const f32x4*)(a.gpost + c), gg = *(const f32x4*)(gt + c);
                f32x4 y = (f32x4){bf_lo(yw.x), bf_hi(yw.x), bf_lo(yw.y), bf_hi(yw.y)};
                v[j] = v[j] + gg * (y * rstd * gp);
                *(f32x4*)(xo + c) = v[j]; }
        }
        if (a.write_xn) {
            float s2 = 0.f;
#pragma unroll
            for (int j = 0; j < 4; ++j) s2 += (v[j][0] * v[j][0] + v[j][1] * v[j][1]) + (v[j][2] * v[j][2] + v[j][3] * v[j][3]);
            const float rstd = rsqrtf(wave_sum(s2) * (1.f / DM) + EPS);
            const float* mn = a.mod_nxt + (size_t)rb * NMOD;
#pragma unroll
            for (int j = 0; j < 4; ++j) { const int c = 4 * lane + 256 * j;
                const f32x4 gp = *(const f32x4*)(a.gpre + c), sh = *(const f32x4*)(mn + a.sh_off + c), sc = *(const f32x4*)(mn + a.sc_off + c);
                const f32x4 h = (v[j] * rstd * gp) * (sc + 1.f) + sh;
                u32x2 w; w.x = cvt_pk_bf16(h[0], h[1]); w.y = cvt_pk_bf16(h[2], h[3]);
                *(u32x2*)(XN + (size_t)m * DM + c) = w; }
        }
    }
}

constexpr float LOG2E = 1.4426950408889634f;
constexpr int RPB_PITCH = 64, RPB_OFF = 16;

__device__ __forceinline__ void attn_unit(const bf16_t* PB, const bf16_t* VT, bf16_t* MIX, const LAS float* rpbs, int b, int h, int r, int n, bool is_cq, int cq, int lane) {
    const int qi = lane & 15, g = lane >> 4;
    const int qtok = is_cq ? (ML + b * CT + 16 * cq + qi) : (b * SEQ + r * 64 + 16 * n + qi);
    const bf16_t* qp = PB + (size_t)qtok * PBW + 512 + h * 64 + 8 * g;
    const bf16x8 q0 = *(const bf16x8*)qp, q1 = *(const bf16x8*)(qp + 32);
    const int rs = min(max(r - 4, 0), 56), kc0 = min(max(16 * n - 8, 0), 32);
    const int kap = 8 * (qi >> 2) + (qi & 3);
    const int qc = 16 * n + qi, qs = min(max(qc - 8, 0), 48);
    constexpr float SC = 0.125f * LOG2E;
    float mx = -INFINITY, lsum = 0.f;
    f32x4 o[4];
#pragma unroll
    for (int dt = 0; dt < 4; ++dt) o[dt] = (f32x4){0.f, 0.f, 0.f, 0.f};
#pragma unroll 1
    for (int hf = is_cq ? 1 : 0; hf < 2; ++hf) {
        const bool loc = (hf == 0);
        const int elo = loc ? (qs - kc0 - 8 * g) : -1000, ehi = loc ? (elo + 16) : 1000;
        const LAS float* bp = loc ? rpbs + (h * 15 + rs - r + 7) * RPB_PITCH + RPB_OFF + (kc0 + 8 * g - qc + 15) : rpbs + 8 * 15 * RPB_PITCH;
        const int bstr = loc ? RPB_PITCH : 0;
        const int ktok0 = loc ? (b * SEQ + rs * 64 + kc0) : (ML + b * CT), kstr = loc ? 64 : 32;
        const bf16_t* kb = PB + (size_t)(ktok0 + kap) * PBW + 1024 + h * 64 + 8 * g;
        const bf16_t* vb = VT + (size_t)(h * 64 + qi) * MT + (ktok0 + 8 * g);
        float s[8][8];
#pragma unroll
        for (int c = 0; c < 8; ++c) {
            const bf16_t* kp = kb + (size_t)(c * kstr) * PBW;
            const bf16x8 a00 = *(const bf16x8*)kp, a01 = *(const bf16x8*)(kp + 32), a10 = *(const bf16x8*)(kp + 4 * PBW), a11 = *(const bf16x8*)(kp + 4 * PBW + 32);
            f32x4 t0 = (f32x4){0.f, 0.f, 0.f, 0.f}, t1 = (f32x4){0.f, 0.f, 0.f, 0.f};
            t0 = __builtin_amdgcn_mfma_f32_16x16x32_bf16(a00, q0, t0, 0, 0, 0); t0 = __builtin_amdgcn_mfma_f32_16x16x32_bf16(a01, q1, t0, 0, 0, 0);
            t1 = __builtin_amdgcn_mfma_f32_16x16x32_bf16(a10, q0, t1, 0, 0, 0); t1 = __builtin_amdgcn_mfma_f32_16x16x32_bf16(a11, q1, t1, 0, 0, 0);
#pragma unroll
            for (int e = 0; e < 8; ++e) { const float a = (e < 4) ? t0[e] : t1[e - 4]; const float bv = bp[c * bstr + e];
                const bool ok = (e >= elo) && (e < ehi); s[c][e] = ok ? (a * SC + bv) : -INFINITY; }
        }
        float m2 = mx;
#pragma unroll
        for (int c = 0; c < 8; ++c)
#pragma unroll
            for (int e = 0; e < 8; ++e) m2 = fmaxf(m2, s[c][e]);
        m2 = fmaxf(m2, __shfl_xor(m2, 16)); m2 = fmaxf(m2, __shfl_xor(m2, 32));
        const float alpha = __builtin_amdgcn_exp2f(mx - m2);
        mx = m2; lsum *= alpha;
#pragma unroll
        for (int dt = 0; dt < 4; ++dt) o[dt] = o[dt] * alpha;
#pragma unroll
        for (int c = 0; c < 8; ++c) {
            float pe[8];
#pragma unroll
            for (int e = 0; e < 8; ++e) { pe[e] = __builtin_amdgcn_exp2f(s[c][e] - mx); lsum += pe[e]; }
            u32x4 pw; pw.x = cvt_pk_bf16(pe[0], pe[1]); pw.y = cvt_pk_bf16(pe[2], pe[3]); pw.z = cvt_pk_bf16(pe[4], pe[5]); pw.w = cvt_pk_bf16(pe[6], pe[7]);
            const bf16x8 pb = __builtin_bit_cast(bf16x8, pw);
            const bf16_t* vp = vb + c * kstr;
#pragma unroll
            for (int dt = 0; dt < 4; ++dt) { const bf16x8 vf = *(const bf16x8*)(vp + (size_t)(16 * dt) * MT); o[dt] = __builtin_amdgcn_mfma_f32_16x16x32_bf16(vf, pb, o[dt], 0, 0, 0); }
        }
    }
    lsum += __shfl_xor(lsum, 16); lsum += __shfl_xor(lsum, 32);
    const float inv = 1.f / lsum;
    bf16_t* op = MIX + (size_t)qtok * DM + 512 + h * 64 + 4 * g;
#pragma unroll
    for (int dt = 0; dt < 4; ++dt) { u32x2 w; w.x = cvt_pk_bf16(o[dt][0] * inv, o[dt][1] * inv); w.y = cvt_pk_bf16(o[dt][2] * inv, o[dt][3] * inv); *(u32x2*)(op + 16 * dt) = w; }
}

__device__ __forceinline__ void phase_mixer(const Params& p, LAS unsigned char* lds, int l, bool with_ctx, int G, int tid, int wave, int lane) {
    const bf16_t* PB = (const bf16_t*)(p.ws + WS_PB); const bf16_t* VT = (const bf16_t*)(p.ws + WS_VT); bf16_t* MIX = (bf16_t*)(p.ws + WS_MIX);
    LAS float* rpbs = (LAS float*)lds;
    for (int i = tid; i < (8 * 15 + 1) * RPB_PITCH; i += NTHR) { const int row = i >> 6, cc = (i & 63) - RPB_OFF; rpbs[i] = (row < 120 && cc >= 0 && cc < 31) ? p.in[I_RPB][(size_t)l * 8 * 15 * 31 + row * 31 + cc] * LOG2E : 0.f; }
    __syncthreads();
    const int gw = blockIdx.x * NWAVES + wave, NGW = G * NWAVES;
    {
        const int nx = ((G & 7) == 0) ? 8 : 1, x = blockIdx.x % nx, j = blockIdx.x / nx, wpx = (G / nx) * NWAVES, lim = (64 / nx) * 256;
        const int nit_lat = (lim + wpx - 1) / wpx, nit_ctx = with_ctx ? (64 * 16 + NGW - 1) / NGW : 0;
#pragma unroll 1
        for (int it = 0; it < nit_lat + nit_ctx; ++it) {
            int b, h, r = 0, n = 0, cq = 0; bool is_cq = false;
            if (it < nit_lat) { const int idx = it * wpx + j * NWAVES + wave; if (idx >= lim) continue; const int pr = (idx >> 8) * nx + x, q = idx & 255; b = pr >> 3; h = pr & 7; r = q >> 2; n = q & 3; }
            else { const int u = (it - nit_lat) * NGW + gw; if (u >= 64 * 16) continue; const int pr = u >> 4; b = pr >> 3; h = pr & 7; cq = u & 15; is_cq = true; }
            attn_unit(PB, VT, MIX, rpbs, b, h, r, n, is_cq, cq, lane);
        }
    }
    const int ntok = with_ctx ? MT : ML;
    const int grp = lane >> 4, lo = 1 << grp, hi = lo - 1;
    for (int tok = gw; tok < ntok; tok += NGW) {
        const bool isl = tok < ML; const int base = isl ? (tok & ~(SEQ - 1)) : (ML + ((tok - ML) & ~(CT - 1))), len = isl ? SEQ : CT, t = tok - base;
        const int st = max(t - lo, 0), en = min(t + hi + 1, len);
        float acc[8];
#pragma unroll
        for (int e = 0; e < 8; ++e) acc[e] = 0.f;
        float self[8];
#pragma unroll
        for (int dt = -8; dt < 8; ++dt) { const int tt = t + dt;
            if (tt >= st && tt < en) { const u32x4 w = *(const u32x4*)(PB + (size_t)(base + tt) * PBW + 8 * lane);
                float f[8] = {bf_lo(w.x), bf_hi(w.x), bf_lo(w.y), bf_hi(w.y), bf_lo(w.z), bf_hi(w.z), bf_lo(w.w), bf_hi(w.w)};
#pragma unroll
                for (int e = 0; e < 8; ++e) acc[e] += f[e];
                if (dt == 0) {
#pragma unroll
                    for (int e = 0; e < 8; ++e) self[e] = f[e]; } } }
        const float ic = 1.f / (float)(en - st);
        u32x4 o; o.x = cvt_pk_bf16(acc[0] * ic - self[0], acc[1] * ic - self[1]); o.y = cvt_pk_bf16(acc[2] * ic - self[2], acc[3] * ic - self[3]);
        o.z = cvt_pk_bf16(acc[4] * ic - self[4], acc[5] * ic - self[5]); o.w = cvt_pk_bf16(acc[6] * ic - self[6], acc[7] * ic - self[7]);
        *(u32x4*)(MIX + (size_t)tok * DM + 8 * lane) = o;
    }
    __syncthreads();
}

constexpr int NPHASE = 2 + 7 * DEPTH;
__global__ void __launch_bounds__(NTHR) fwd_kernel(Params p) {
    extern __shared__ __attribute__((aligned(16))) unsigned char lds_raw[];
    LAS unsigned char* lds = (LAS unsigned char*)lds_raw;
    const int G = gridDim.x;
    const int ph_hi = p.ph_hi;
    for (int ph = p.ph_lo; ph < ph_hi; ++ph) {
        int z = 0; asm volatile("s_mov_b32 %0, 0" : "=s"(z));
        Params q;
#pragma unroll
        for (int i = 0; i < 17; ++i) q.in[i] = p.in[i] + z;
        q.out = p.out + z; q.ws = p.ws + z; q.ph_lo = 0; q.ph_hi = 0;
        const int tid = threadIdx.x + z, lane = tid & 63, wave = __builtin_amdgcn_readfirstlane(tid >> 6);
        const float* mod = (const float*)(q.ws + WS_MOD);
        bf16_t* XN = (bf16_t*)(q.ws + WS_XN);
        float* ctxr = (float*)(q.ws + WS_CTXR);
        if (ph == 0) phase_prologue(q, lds, G, tid, wave, lane);
        else if (ph == 1) {
            RowArgs a{}; a.xlat = q.in[I_X]; a.xctx = q.in[I_CTX]; a.nrows = MT; a.has_y = false; a.write_xn = true;
            a.gpre = q.in[I_GPREMIX]; a.mod_nxt = mod; a.sh_off = 0; a.sc_off = DM;
            phase_rows(q, a, G, wave, lane);
        } else {
            const int l = (ph - 2) / 7, s = (ph - 2) % 7; const bool last = (l == DEPTH - 1);
            const int nMrows = last ? ML / 256 : MT / 256;
            if (s == 0) {
                pg8::Gemm g{XN, (const bf16_t*)(q.ws + WS_WIN) + (size_t)l * NIN * DM, DM, 6};
                pg8::StaticOrder S; S.init(MT / 256, 8, G, (int)blockIdx.x);
                pg8::Epi<0> E{(bf16_t*)(q.ws + WS_PB), (bf16_t*)(q.ws + WS_VT), nullptr};
                pg8::gemm_phase<pg8::Epi<0>, true>(lds, g, S, E, tid);
            } else if (s == 1) {
                phase_mixer(q, lds, l, !last, G, tid, wave, lane);
            } else if (s == 2) {
                pg8::Gemm g{(const bf16_t*)(q.ws + WS_MIX), (const bf16_t*)(q.ws + WS_WOUT) + (size_t)l * DM * DM, DM, 1 << 30};
                pg8::StaticOrder S; S.init(nMrows, 4, G, (int)blockIdx.x);
                pg8::Epi<1> E{XN, nullptr, (float*)(q.ws + WS_SS)};
                pg8::gemm_phase<pg8::Epi<1>, true>(lds, g, S, E, tid);
            } else if (s == 3) {
                RowArgs a{}; a.xlat = (l == 0) ? q.in[I_X] : q.out; a.xctx = (l == 0) ? q.in[I_CTX] : ctxr; a.olat = q.out; a.octx = ctxr;
                a.gpost = q.in[I_GPOSTMIX] + l * DM; a.mod_cur = mod + (size_t)l * 9 * NMOD; a.gate_off = 2 * DM;
                a.gpre = q.in[I_GPREMLP] + l * DM; a.mod_nxt = a.mod_cur; a.sh_off = 3 * DM; a.sc_off = 4 * DM;
                a.nrows = nMrows * 256; a.has_y = true; a.write_xn = true;
                phase_rows(q, a, G, wave, lane);
            } else if (s == 4) {
                pg8::Gemm g{XN, (const bf16_t*)(q.ws + WS_W1) + (size_t)l * FF * DM, DM, 1 << 30};
                pg8::StaticOrder S; S.init(nMrows, 16, G, (int)blockIdx.x);
                pg8::Epi<2> E{(bf16_t*)(q.ws + WS_H), nullptr, nullptr};
                pg8::gemm_phase<pg8::Epi<2>, true>(lds, g, S, E, tid);
            } else if (s == 5) {
                pg8::Gemm g{(const bf16_t*)(q.ws + WS_H), (const bf16_t*)(q.ws + WS_W2) + (size_t)l * DM * FF, FF, 1 << 30};
                pg8::StaticOrder S; S.init(nMrows, 4, G, (int)blockIdx.x);
                pg8::Epi<1> E{XN, nullptr, (float*)(q.ws + WS_SS)};
                pg8::gemm_phase<pg8::Epi<1>, true>(lds, g, S, E, tid);
            } else {
                RowArgs a{}; a.xlat = q.out; a.xctx = ctxr; a.olat = q.out; a.octx = ctxr;
                a.gpost = q.in[I_GPOSTMLP] + l * DM; a.mod_cur = mod + (size_t)l * 9 * NMOD; a.gate_off = 5 * DM;
                a.nrows = nMrows * 256; a.has_y = true; a.write_xn = !last;
                if (!last) { a.gpre = q.in[I_GPREMIX] + (l + 1) * DM; a.mod_nxt = mod + (size_t)(l + 1) * 9 * NMOD; a.sh_off = 0; a.sc_off = DM; }
                phase_rows(q, a, G, wave, lane);
            }
        }
        if (ph + 1 < ph_hi) { cg::this_grid().sync(); }
    }
}

extern "C" void kernel_launch(void* const* d_in, const int* in_sizes, int n_in, void* d_out, int out_size, void* d_ws, size_t ws_size, hipStream_t stream) {
    static int grid = 0;
    if (grid == 0) {
        if (n_in != 17 || in_sizes[0] != ML * DM || out_size != ML * DM || ws_size < WS_END) { fprintf(stderr, "kernel_launch: unexpected shapes (n_in %d, in0 %d, out %d, ws %zu)\n", n_in, n_in > 0 ? in_sizes[0] : -1, out_size, ws_size); grid = -1; return; }
        int dev = 0, cus = 0, per_cu = 0;
        (void)hipGetDevice(&dev);
        (void)hipDeviceGetAttribute(&cus, hipDeviceAttributeMultiprocessorCount, dev);
        if (hipFuncSetAttribute((const void*)fwd_kernel, hipFuncAttributeMaxDynamicSharedMemorySize, LDS_BYTES) != hipSuccess) { fprintf(stderr, "kernel_launch: hipFuncSetAttribute failed\n"); grid = -1; return; }
        if (hipOccupancyMaxActiveBlocksPerMultiprocessor(&per_cu, (const void*)fwd_kernel, NTHR, LDS_BYTES) != hipSuccess || per_cu < 1) { fprintf(stderr, "kernel_launch: occupancy query says %d\n", per_cu); per_cu = 1; }
        (void)hipGetLastError();
        grid = cus * 1;
    }
    if (grid < 0) return;
    Params p{};
    for (int i = 0; i < 17; ++i) p.in[i] = (const float*)d_in[i];
    p.out = (float*)d_out; p.ws = (unsigned char*)d_ws;
#if MK_SPLIT
    for (int ph = 0; ph < NPHASE; ++ph) { p.ph_lo = ph; p.ph_hi = ph + 1; hipLaunchKernelGGL(fwd_kernel, dim3(grid), dim3(NTHR), LDS_BYTES, stream, p); }
#else
    p.ph_lo = 0; p.ph_hi = NPHASE;
    void* args[] = {&p};
    hipError_t e = hipLaunchCooperativeKernel((const void*)fwd_kernel, dim3(grid), dim3(NTHR), args, LDS_BYTES, stream);
    if (e != hipSuccess) fprintf(stderr, "cooperative launch failed: %s (grid %d)\n", hipGetErrorString(e), grid);
#endif
}
```

```cpp
#include <hip/hip_runtime.h>
#include <hip/hip_cooperative_groups.h>
#include <cstdio>
#include <cstdint>
namespace cg = cooperative_groups;

#ifndef MK_SPLIT
#define MK_SPLIT 0
#endif

#ifndef PROBE_DUP
#define PROBE_DUP 0
#endif
#define LAS __attribute__((address_space(3)))
typedef unsigned short bf16_t;
typedef short bf16x8 __attribute__((ext_vector_type(8)));
typedef float f32x4 __attribute__((ext_vector_type(4)));
typedef float f32x2 __attribute__((ext_vector_type(2)));
typedef unsigned u32x4 __attribute__((ext_vector_type(4)));
typedef unsigned u32x2 __attribute__((ext_vector_type(2)));

constexpr int DM = 1024, NB = 8, SEQ = 4096, CT = 256, DEPTH = 4, FF = 4096, NIN = 2048;
constexpr int ML = NB * SEQ, MC = NB * CT, MT = ML + MC;
constexpr int NMOD = 6 * DM;
constexpr int VTP = MT + 128;
constexpr int PBW = 1536;
constexpr float EPS = 1e-6f;
constexpr int NWAVES = 8, NTHR = 512;

constexpr size_t MiB = 1u << 20;
constexpr size_t WS_MOD = 0;
constexpr size_t WS_SS = 1 * MiB;
constexpr size_t WS_BAR = 3 * MiB + 512 * 1024;
constexpr size_t WS_CTXR = 4 * MiB;
constexpr size_t WS_WIN = 12 * MiB;
constexpr size_t WS_WOUT = 28 * MiB;
constexpr size_t WS_W1 = 36 * MiB;
constexpr size_t WS_W2 = 68 * MiB;
constexpr size_t WS_XN = 100 * MiB;
constexpr size_t WS_H = 168 * MiB;
constexpr size_t WS_PB = WS_H;
constexpr size_t WS_VT = 270 * MiB;
constexpr size_t WS_MIX = 306 * MiB;
constexpr size_t WS_XR = 440 * MiB;
constexpr size_t WS_END = 504 * MiB;
static_assert(WS_PB + (size_t)MT * PBW * 2 <= WS_VT && WS_VT + (size_t)512 * VTP * 2 <= WS_MIX && WS_MIX + (size_t)MT * DM * 2 <= WS_END, "ws");
static_assert(WS_H + (size_t)MT * FF * 2 <= WS_XR && WS_XR + (size_t)ML * DM * 2 <= WS_END && (size_t)8 * MC * DM * 4 <= (size_t)ML * DM * 4, "ws h");

constexpr int LDS_BYTES = 163840;

typedef __bf16 bf16v2 __attribute__((ext_vector_type(2)));
__device__ __forceinline__ unsigned cvt_pk_bf16(float lo, float hi) { const f32x2 v = (f32x2){lo, hi}; return __builtin_bit_cast(unsigned, __builtin_convertvector(v, bf16v2)); }
__device__ __forceinline__ float bf_lo(unsigned w) { return __uint_as_float(w << 16); }
__device__ __forceinline__ float bf_hi(unsigned w) { return __uint_as_float(w & 0xffff0000u); }
__device__ __forceinline__ float wave_sum(float v) {
#pragma unroll
    for (int o = 1; o < 64; o <<= 1) v += __shfl_xor(v, o);
    return v;
}
#define LDS_WAIT() asm volatile("s_waitcnt lgkmcnt(0)" ::: "memory")

namespace pg8 {
constexpr int BM = 256, BK = 64, HALF = 128, HTB = HALF * BK * 2, STAGE_BYTES = 8 * HTB, NXCD = 8, WGM = 8;
__host__ __device__ __forceinline__ int lds_byte(int r, int c) { const int st = (r >> 4) * 2 + (c >> 5), rr = r & 15, cc = c & 31, ob = rr * 64 + cc * 2; return st * 1024 + (ob ^ (((ob >> 9) & 1) << 5)); }
__host__ __device__ __forceinline__ void stage_rc(int b, int& R, int& C) { const int st = b / 1024, sb = b % 1024, swz = sb ^ (((sb >> 9) & 1) << 5); R = (st >> 1) * 16 + swz / 64; C = (st & 1) * 32 + (swz % 64) / 2; }
__host__ __device__ __forceinline__ int perm32(int rho) { const int n = rho >> 4, i = rho & 15; return 8 * (i >> 2) + 4 * n + (i & 3); }

struct Unit { int pm, pn, ks; };
constexpr int KSPLIT = 8;
struct Gemm { const bf16_t* A; const bf16_t* Bt; int K; int nN_main; };

struct StaticOrder {
    int nM, nN, nwg, G, c, nsplit;
    __device__ __forceinline__ void init(int nM_, int nN_, int G_, int c_, int nsplit_ = 0) { nM = nM_; nN = nN_; nwg = nM * nN; G = G_; c = c_; nsplit = nsplit_; }
    __device__ __forceinline__ bool next(int i, Unit& u) const {
        const long L = (long)i * G + c; if (L >= nwg + nsplit * nN * KSPLIT) return false;
        int pm, pn, ks;
        if (L >= nwg) { const int e = (int)L - nwg, cu = e / KSPLIT; ks = e % KSPLIT; pm = nM + cu / nN; pn = cu % nN; }
        else {
            int wgid = (int)L; { const int q = nwg / NXCD, r = nwg % NXCD, xcd = wgid % NXCD, off = wgid / NXCD; wgid = (xcd < r ? xcd * (q + 1) : r * (q + 1) + (xcd - r) * q) + off; }
            const int nig = WGM * nN, gid = wgid / nig, fm = gid * WGM, gsz = (nM - fm) < WGM ? (nM - fm) : WGM;
            pm = fm + ((wgid % nig) % gsz); pn = (wgid % nig) / gsz; ks = -1;
        }
        u.pm = pm; u.pn = pn; u.ks = ks; return true;
    }
};

template <int MODE> struct Epi {
    bf16_t* O; bf16_t* O2; float* part;
    __device__ __forceinline__ void operator()(const f32x4 (&acc)[2][2][4][2], const Unit& u, int wr, int wc, int fr, int fq) const {
        int prow = u.pm, pcol = u.pn; bf16_t* base = O; size_t ldc = (MODE == 0) ? PBW : (MODE == 1 ? DM : FF);
        if (MODE == 0 && u.pn >= 6) { prow = u.pn - 6; pcol = u.pm; base = O2; ldc = VTP; }
        const int row0 = prow * BM + wr * 64 + fr, col0 = pcol * BM + wc * 32 + 8 * fq;
        if (MODE == 1 && u.ks >= 0) {
            float* pb = part + ((size_t)u.ks * MC + (size_t)(row0 - ML)) * DM + col0;
#pragma unroll
            for (int ai = 0; ai < 2; ++ai)
#pragma unroll
                for (int m = 0; m < 4; ++m) { float* rowp = pb + (size_t)(ai * HALF + m * 16) * DM;
#pragma unroll
                    for (int bj = 0; bj < 2; ++bj) { *(f32x4*)(rowp + bj * HALF) = acc[ai][bj][m][0]; *(f32x4*)(rowp + bj * HALF + 4) = acc[ai][bj][m][1]; } }
            return;
        }
#pragma unroll
        for (int ai = 0; ai < 2; ++ai)
#pragma unroll
            for (int m = 0; m < 4; ++m) { bf16_t* rowp = base + (size_t)(row0 + ai * HALF + m * 16) * ldc + col0;
#pragma unroll
                for (int bj = 0; bj < 2; ++bj) { f32x4 v0 = acc[ai][bj][m][0], v1 = acc[ai][bj][m][1];
                    if (MODE == 2) {
#pragma unroll
                        for (int e = 0; e < 4; ++e) { const float a = fmaxf(v0[e], 0.f), b = fmaxf(v1[e], 0.f); v0[e] = a * a; v1[e] = b * b; } }
                    u32x4 w; w.x = cvt_pk_bf16(v0[0], v0[1]); w.y = cvt_pk_bf16(v0[2], v0[3]); w.z = cvt_pk_bf16(v1[0], v1[1]); w.w = cvt_pk_bf16(v1[2], v1[3]);
                    *(u32x4*)(rowp + bj * HALF) = w; } }
    }
};

template <class EpiT, bool ALIGN_EPI>
__device__ __forceinline__ void gemm_phase(LAS unsigned char* lds, const Gemm g, const StaticOrder& S, const EpiT& E, const int tid) {
    const int wid = __builtin_amdgcn_readfirstlane(tid >> 6), lane = tid & 63, wr = wid >> 2, wc = wid & 3, fr = lane & 15, fq = lane >> 4;
    const int K = g.K;
    unsigned voffA[2], voffB[2];
#pragma unroll
    for (int i = 0; i < 2; ++i) { int R, C; stage_rc(tid * 16 + i * 8192, R, C); const int Rb = (R & ~31) + perm32(R & 31);
        voffA[i] = (unsigned)(R * K + C) * 2u; voffB[i] = (unsigned)(Rb * K + C) * 2u; }
    const size_t kstep = (size_t)(BK * 2);
    const size_t hstep = (size_t)HALF * K * 2;
    const size_t tstep = 2 * hstep;
    const unsigned ldsw = (unsigned)wid * 1024u;
    const int aoff = lds_byte(wr * 64 + fr, fq * 8), boff = lds_byte(wc * 32 + fr, fq * 8);
#define PG8_SA(b, h) (((b) * 2 + (h)) * HTB)
#define PG8_SB(b, h) ((4 + (b) * 2 + (h)) * HTB)
#define PG8_STAGE(bufoff, gbase, voff) do { _Pragma("unroll") for (int _i = 0; _i < 2; ++_i) \
        __builtin_amdgcn_global_load_lds((const unsigned*)((const char*)(gbase) + (voff)[_i]), (LAS unsigned*)(lds + (bufoff) + ldsw + _i * 8192), 16, 0, 0); } while (0)
#define PG8_LDA(dst, b, h) do { _Pragma("unroll") for (int m = 0; m < 4; ++m) _Pragma("unroll") for (int k = 0; k < 2; ++k) dst[m][k] = *(const LAS bf16x8*)(lds + PG8_SA(b, h) + aoff + m * 2048 + k * 1024); } while (0)
#define PG8_LDB(dst, b, h) do { _Pragma("unroll") for (int n = 0; n < 2; ++n) _Pragma("unroll") for (int k = 0; k < 2; ++k) dst[n][k] = *(const LAS bf16x8*)(lds + PG8_SB(b, h) + boff + n * 2048 + k * 1024); } while (0)
#define PG8_MMA(ai, bj, At, Bt) do { __builtin_amdgcn_s_setprio(1); _Pragma("unroll") for (int m = 0; m < 4; ++m) _Pragma("unroll") for (int n = 0; n < 2; ++n) _Pragma("unroll") for (int k = 0; k < 2; ++k) \
        acc[ai][bj][m][n] = __builtin_amdgcn_mfma_f32_16x16x32_bf16(Bt[n][k], At[m][k], acc[ai][bj][m][n], 0, 0, 0); __builtin_amdgcn_s_setprio(0); } while (0)
#define PG8_WAIT_V(n) asm volatile("s_waitcnt vmcnt(" #n ")" ::: "memory")
#define PG8_WAIT_L(n) asm volatile("s_waitcnt lgkmcnt(" #n ")" ::: "memory")
#define PG8_BAR __builtin_amdgcn_s_barrier()
#define PG8_SCHED __builtin_amdgcn_sched_barrier(0)
#define PG8_PTRS(u, pa, pb) do { const size_t _ko = (u).ks >= 0 ? (size_t)(u).ks * (size_t)(K / KSPLIT) * 2 : 0; \
        const char* _a = (const char*)g.A + (size_t)(u).pm * tstep + _ko; const char* _b = (const char*)g.Bt + (size_t)(u).pn * tstep + _ko; \
        if ((u).pn >= g.nN_main) { pa = _b; pb = _a; } else { pa = _a; pb = _b; } } while (0)
    Unit cur, nxt; int ui = 0;
    if (!S.next(0, cur)) return;
    f32x4 acc[2][2][4][2];
#pragma unroll
    for (int a = 0; a < 2; ++a)
#pragma unroll
        for (int b = 0; b < 2; ++b)
#pragma unroll
            for (int m = 0; m < 4; ++m)
#pragma unroll
                for (int n = 0; n < 2; ++n) acc[a][b][m][n] = (f32x4){0.f, 0.f, 0.f, 0.f};
    bf16x8 At[4][2], B0[2][2], B1[2][2];
    const char* cA; const char* cB; PG8_PTRS(cur, cA, cB);
    PG8_STAGE(PG8_SB(0, 0), cB, voffB); PG8_STAGE(PG8_SB(0, 1), cB + hstep, voffB); PG8_STAGE(PG8_SA(0, 0), cA, voffA); PG8_STAGE(PG8_SA(0, 1), cA + hstep, voffA);
    if (wr == 1) PG8_BAR;
    PG8_WAIT_V(2); PG8_BAR;
    PG8_STAGE(PG8_SB(1, 0), cB + kstep, voffB); PG8_STAGE(PG8_SA(1, 0), cA + kstep, voffA); PG8_STAGE(PG8_SB(1, 1), cB + hstep + kstep, voffB);
    PG8_WAIT_V(6); PG8_BAR;
    for (;;) {
        const bool has_next = S.next(ui + 1, nxt);
        const char* nA = cA; const char* nB = cB; if (has_next) PG8_PTRS(nxt, nA, nB);
        const int nt = (cur.ks >= 0) ? (K / KSPLIT) / BK : K / BK;
        for (int t = 0; t < nt; t += 2) {
            const bool last = (t == nt - 2);
            const char* a1 = cA + (size_t)(t + 1) * kstep;
            const char* a2 = last ? nA : cA + (size_t)(t + 2) * kstep; const char* b2 = last ? nB : cB + (size_t)(t + 2) * kstep;
            const char* a3 = a2 + kstep; const char* b3 = b2 + kstep;
            PG8_LDB(B0, 0, 0); PG8_LDB(B1, 0, 1); PG8_SCHED; PG8_LDA(At, 0, 0); PG8_STAGE(PG8_SA(1, 1), a1 + hstep, voffA);
            PG8_WAIT_V(8); PG8_WAIT_L(0); PG8_BAR; PG8_MMA(0, 0, At, B0); PG8_MMA(0, 1, At, B1); PG8_BAR; PG8_SCHED;
            PG8_LDA(At, 0, 1); PG8_STAGE(PG8_SB(0, 0), b2, voffB); PG8_STAGE(PG8_SB(0, 1), b2 + hstep, voffB); PG8_STAGE(PG8_SA(0, 0), a2, voffA);
            PG8_WAIT_V(8); PG8_WAIT_L(0); PG8_BAR; PG8_MMA(1, 0, At, B0); PG8_MMA(1, 1, At, B1); PG8_BAR; PG8_SCHED;
            PG8_LDB(B0, 1, 0); PG8_LDB(B1, 1, 1); PG8_SCHED; PG8_LDA(At, 1, 0); PG8_STAGE(PG8_SA(0, 1), a2 + hstep, voffA);
            PG8_WAIT_V(8); PG8_WAIT_L(0); PG8_BAR; PG8_MMA(0, 0, At, B0); PG8_MMA(0, 1, At, B1); PG8_BAR; PG8_SCHED;
            PG8_LDA(At, 1, 1); PG8_STAGE(PG8_SB(1, 0), b3, voffB); PG8_STAGE(PG8_SB(1, 1), b3 + hstep, voffB); PG8_STAGE(PG8_SA(1, 0), a3, voffA);
            PG8_WAIT_V(8); PG8_WAIT_L(0); PG8_BAR; PG8_MMA(1, 0, At, B0); PG8_MMA(1, 1, At, B1); PG8_BAR; PG8_SCHED;
        }
        if constexpr (ALIGN_EPI) { if (wr == 0) PG8_BAR; }
        E(acc, cur, wr, wc, fr, fq);
        if (!has_next) break;
#pragma unroll
        for (int a = 0; a < 2; ++a)
#pragma unroll
            for (int b = 0; b < 2; ++b)
#pragma unroll
                for (int m = 0; m < 4; ++m)
#pragma unroll
                    for (int n = 0; n < 2; ++n) acc[a][b][m][n] = (f32x4){0.f, 0.f, 0.f, 0.f};
        cur = nxt; cA = nA; cB = nB; ++ui;
        if constexpr (ALIGN_EPI) { if (wr == 1) PG8_BAR; }
    }
    PG8_WAIT_V(0);
    if constexpr (!ALIGN_EPI) { if (wr == 0) PG8_BAR; }
    PG8_BAR;
#undef PG8_SA
#undef PG8_SB
#undef PG8_STAGE
#undef PG8_LDA
#undef PG8_LDB
#undef PG8_MMA
#undef PG8_WAIT_V
#undef PG8_WAIT_L
#undef PG8_BAR
#undef PG8_SCHED
#undef PG8_PTRS
}
}

#define XB_TMO      128
#define XB_XCNT(j)  (256  + 64 * (j))
#define XB_XSUB(j)  (1280 + 64 * (j))
#define XB_XGEN(j)  (2304 + 64 * (j))
#define XB_TOP      3328
#define XB_TOPGEN   3392
#define XCD_BAR_WORDS 3456
#define XB_SPIN_CAP (1u << 18)
__device__ __forceinline__ unsigned xb_ld(unsigned* p)              { return __hip_atomic_load(p, __ATOMIC_RELAXED, __HIP_MEMORY_SCOPE_AGENT); }
__device__ __forceinline__ unsigned xb_add(unsigned* p, unsigned v) { return __hip_atomic_fetch_add(p, v, __ATOMIC_RELAXED, __HIP_MEMORY_SCOPE_AGENT); }
__device__ __forceinline__ unsigned xb_xcc_id() { return (unsigned)__builtin_amdgcn_s_getreg((3 << 11) | 20) & 0xFu; }
#define XB_SPIN(cond, bar) do { unsigned _sp = 0; while (cond) { __builtin_amdgcn_s_sleep(1); \
    if ((++_sp & 255u) == 0u) { if (xb_ld(&(bar)[XB_TMO])) break; if (_sp > XB_SPIN_CAP) { atomicAdd(&(bar)[XB_TMO], 1u); break; } } } } while (0)
struct XcdBarrier { unsigned* bar; unsigned x; volatile LAS unsigned* st; };
__device__ __forceinline__ XcdBarrier xcd_barrier_post(unsigned* bar, volatile LAS unsigned* st) {
    XcdBarrier b; b.bar = bar; b.x = xb_xcc_id(); b.st = st;
    if (threadIdx.x == 0) (void)xb_add(&bar[XB_XCNT(b.x)], 1u);
    return b;
}
__device__ __forceinline__ void xcd_barrier_complete(unsigned* bar, unsigned x, unsigned& nloc, unsigned& nx) {
    const unsigned G = gridDim.x * gridDim.y * gridDim.z;
    unsigned sum, cnt, mine, sp = 0u;
    for (;;) {
        sum = 0u; cnt = 0u; mine = 0u;
#pragma unroll
        for (unsigned j = 0; j < 16; ++j) { const unsigned c = xb_ld(&bar[XB_XCNT(j)]); sum += c; cnt += (c > 0u) ? 1u : 0u; mine = (j == x) ? c : mine; }
        if (sum == G) break;
        __builtin_amdgcn_s_sleep(1);
        if ((++sp & 255u) == 0u) { if (xb_ld(&bar[XB_TMO])) break; if (sp > XB_SPIN_CAP) { atomicAdd(&bar[XB_TMO], 1u); break; } }
    }
    nloc = mine > 0u ? mine : 1u; nx = cnt > 0u ? cnt : 1u;
}
__device__ __forceinline__ void xcd_barrier(const XcdBarrier& b) {
    asm volatile("s_waitcnt vmcnt(0)" ::: "memory");
    __syncthreads();
    if (threadIdx.x == 0) {
        unsigned* bar = b.bar;
        __builtin_amdgcn_s_waitcnt(0);
        unsigned nloc = b.st[0], nx = b.st[1];
        if (nloc == 0u) { xcd_barrier_complete(bar, b.x, nloc, nx); b.st[0] = nloc; b.st[1] = nx; }
        const unsigned old = xb_add(&bar[XB_XSUB(b.x)], 1u);
        const unsigned gen = old / nloc;
        if (old + 1u == (gen + 1u) * nloc) {
            __builtin_amdgcn_fence(__ATOMIC_RELEASE, "agent");
            asm volatile("s_waitcnt vmcnt(0)" ::: "memory");
            const unsigned og = xb_add(&bar[XB_TOP], 1u);
            const unsigned tg = og / nx;
            if (og + 1u == (tg + 1u) * nx) xb_add(&bar[XB_TOPGEN], 1u);
            else XB_SPIN(xb_ld(&bar[XB_TOPGEN]) == tg, bar);
            __builtin_amdgcn_fence(__ATOMIC_ACQUIRE, "agent");
            xb_add(&bar[XB_XGEN(b.x)], 1u);
            asm volatile("s_waitcnt vmcnt(0)" ::: "memory");
        } else {
            XB_SPIN(xb_ld(&bar[XB_XGEN(b.x)]) == gen, bar);
            __builtin_amdgcn_fence(__ATOMIC_ACQUIRE, "agent");
            asm volatile("s_waitcnt vmcnt(0)" ::: "memory");
        }
    }
    __syncthreads();
}

struct Params {
    const float* in[17];
    float* out; unsigned char* ws;
    int ph_lo, ph_hi;
};
enum { I_X = 0, I_C, I_CTX, I_CCTX, I_WMOD, I_BMOD, I_GPREMIX, I_GPOSTMIX, I_GPREMLP, I_GPOSTMLP, I_WIN, I_POOLW, I_POOLS, I_RPB, I_WOUT, I_W1, I_W2 };

__device__ __forceinline__ void transpose_item(const float* W, int ldw, bf16_t* WT, int ldt, int kofs, int nblk, LAS float* scr, int item, int lane) {
    const int kb = item / nblk, nb = item % nblk, k0 = 64 * kb, n0 = 32 * nb;
#pragma unroll 8
    for (int i = 0; i < 32; ++i) { const int kk = 2 * i + (lane >> 5); scr[kk * 33 + (lane & 31)] = W[(size_t)(k0 + kk) * ldw + n0 + (lane & 31)]; }
    LDS_WAIT(); asm volatile("" ::: "memory");
    const int c = lane & 7;
#pragma unroll
    for (int j = 0; j < 4; ++j) { const int n = (lane >> 3) + 8 * j; const LAS float* s = scr + (8 * c) * 33 + n;
        u32x4 o; o.x = cvt_pk_bf16(s[0 * 33], s[1 * 33]); o.y = cvt_pk_bf16(s[2 * 33], s[3 * 33]); o.z = cvt_pk_bf16(s[4 * 33], s[5 * 33]); o.w = cvt_pk_bf16(s[6 * 33], s[7 * 33]);
        *(u32x4*)(WT + (size_t)(n0 + n) * ldt + kofs + k0 + 8 * c) = o; }
    LDS_WAIT(); asm volatile("" ::: "memory");
}

__device__ __forceinline__ float silu_f(float v) { return v / (1.f + __expf(-v)); }

__device__ __forceinline__ void mod_item(const Params& p, LAS unsigned char* lds, int item, int tid, int wave, int lane) {
    LAS float* sv = (LAS float*)lds;
    LAS float* part = (LAS float*)(lds + 36864);
    const int l = item / 24, j0 = (item % 24) * 256;
    for (int i = tid; i < 9 * 1024; i += NTHR) { const int r = i >> 10, k = i & 1023; const float v = (r < 8) ? p.in[I_C][r * 1024 + k] : p.in[I_CCTX][k]; sv[i] = silu_f(v); }
    __syncthreads();
    f32x4 acc[9];
#pragma unroll
    for (int r = 0; r < 9; ++r) acc[r] = (f32x4){0.f, 0.f, 0.f, 0.f};
    const float* wp = p.in[I_WMOD] + (size_t)l * DM * NMOD + (size_t)(wave * 128) * NMOD + j0 + 4 * lane;
#pragma unroll 1
    for (int k8 = 0; k8 < 128; k8 += 8) {
        f32x4 wv[8];
#pragma unroll
        for (int u = 0; u < 8; ++u) wv[u] = *(const f32x4*)(wp + (size_t)(k8 + u) * NMOD);
#pragma unroll
        for (int u = 0; u < 8; ++u)
#pragma unroll
            for (int r = 0; r < 9; ++r) { const float s = sv[r * 1024 + wave * 128 + k8 + u]; acc[r] += wv[u] * s; }
    }
#pragma unroll
    for (int r = 0; r < 9; ++r) *(LAS f32x4*)(part + (wave * 9 + r) * 256 + 4 * lane) = acc[r];
    __syncthreads();
    float* mod = (float*)(p.ws + WS_MOD) + (size_t)l * 9 * NMOD;
    for (int i = tid; i < 9 * 256; i += NTHR) { const int r = i >> 8, j = i & 255; float s = p.in[I_BMOD][l * NMOD + j0 + j];
#pragma unroll
        for (int w = 0; w < 8; ++w) s += part[(w * 9 + r) * 256 + j];
        mod[r * NMOD + j0 + j] = s; }
    __syncthreads();
}

__device__ __forceinline__ void weff_item(const Params& p, LAS unsigned char* lds, int item, int tid, int wave, int lane) {
    LAS float* pw = (LAS float*)lds;
    LAS float* wo = (LAS float*)(lds + 128 * 129 * 4);
    const int l = item >> 6, g = (item >> 4) & 3, n0 = (item & 15) * 64;
    const float* pwg = p.in[I_POOLW] + ((size_t)l * 4 + g) * 128 * 128;
    for (int i = tid; i < 128 * 128; i += NTHR) pw[(i >> 7) * 129 + (i & 127)] = pwg[i];
    const float* wog = p.in[I_WOUT] + (size_t)l * DM * DM + (size_t)(g * 128) * DM + n0;
    const float* psg = p.in[I_POOLS] + l * 512 + g * 128;
    for (int i = tid; i < 128 * 64; i += NTHR) { const int d = i >> 6, n = i & 63; wo[i] = wog[(size_t)d * DM + n] * psg[d]; }
    __syncthreads();
    float acc[16];
#pragma unroll
    for (int c = 0; c < 16; ++c) acc[c] = 0.f;
    const int n = lane, cb = wave * 16;
#pragma unroll 4
    for (int d = 0; d < 128; ++d) { const float w = wo[d * 64 + n];
#pragma unroll
        for (int c = 0; c < 16; ++c) acc[c] += pw[(cb + c) * 129 + d] * w; }
    bf16_t* dst = (bf16_t*)(p.ws + WS_WOUT) + (size_t)l * DM * DM + (size_t)(n0 + n) * DM + g * 128 + cb;
    u32x4 o0, o1;
    o0.x = cvt_pk_bf16(acc[0], acc[1]); o0.y = cvt_pk_bf16(acc[2], acc[3]); o0.z = cvt_pk_bf16(acc[4], acc[5]); o0.w = cvt_pk_bf16(acc[6], acc[7]);
    o1.x = cvt_pk_bf16(acc[8], acc[9]); o1.y = cvt_pk_bf16(acc[10], acc[11]); o1.z = cvt_pk_bf16(acc[12], acc[13]); o1.w = cvt_pk_bf16(acc[14], acc[15]);
    *(u32x4*)dst = o0; *(u32x4*)(dst + 8) = o1;
    __syncthreads();
}

__device__ __forceinline__ void phase_prologue(const Params& p, LAS unsigned char* lds, int G, int tid, int wave, int lane) {
    for (int it = blockIdx.x; it < DEPTH * 24; it += G) mod_item(p, lds, it, tid, wave, lane);
    for (int it = blockIdx.x; it < DEPTH * 64; it += G) weff_item(p, lds, it, tid, wave, lane);
    LAS float* scr = (LAS float*)(lds + wave * 16384);
    const int gw = blockIdx.x * NWAVES + wave, NGW = G * NWAVES;
    constexpr int I_IN = 16 * 64, I_O = 8 * 32, I_1 = 16 * 128, I_2 = 64 * 32, I_L = I_IN + I_O + I_1 + I_2;
    for (int it = gw; it < DEPTH * I_L; it += NGW) {
        const int l = it / I_L; int r = it % I_L;
        if (r < I_IN) { transpose_item(p.in[I_WIN] + (size_t)l * DM * NIN, NIN, (bf16_t*)(p.ws + WS_WIN) + (size_t)l * NIN * DM, DM, 0, NIN / 32, scr, r, lane); continue; } r -= I_IN;
        if (r < I_O) { transpose_item(p.in[I_WOUT] + (size_t)l * DM * DM + (size_t)512 * DM, DM, (bf16_t*)(p.ws + WS_WOUT) + (size_t)l * DM * DM, DM, 512, DM / 32, scr, r, lane); continue; } r -= I_O;
        if (r < I_1) { transpose_item(p.in[I_W1] + (size_t)l * DM * FF, FF, (bf16_t*)(p.ws + WS_W1) + (size_t)l * FF * DM, DM, 0, FF / 32, scr, r, lane); continue; } r -= I_1;
        transpose_item(p.in[I_W2] + (size_t)l * FF * DM, DM, (bf16_t*)(p.ws + WS_W2) + (size_t)l * DM * FF, FF, 0, DM / 32, scr, r, lane);
    }
}

struct RowArgs {
    const void* xlat; const void* xctx; bool xin_f32;
    void* olat; void* octx; bool xout_f32;
    const float* gpost; const float* mod_cur;
    int gate_off;
    const float* gpre; const float* mod_nxt; int sh_off, sc_off;
    int nrows; bool has_y, write_xn, ctx_split;
};
__device__ __forceinline__ void phase_rows(const Params& p, const RowArgs& a, int G, int wave, int lane) {
    bf16_t* XN = (bf16_t*)(p.ws + WS_XN);
    const int gw = blockIdx.x * NWAVES + wave, NGW = G * NWAVES;
    f32x4 gpo[4], gpr[4];
#pragma unroll
    for (int j = 0; j < 4; ++j) { const int c = 4 * lane + 256 * j;
        gpo[j] = a.has_y ? *(const f32x4*)(a.gpost + c) : (f32x4){0.f, 0.f, 0.f, 0.f};
        gpr[j] = a.write_xn ? *(const f32x4*)(a.gpre + c) : (f32x4){0.f, 0.f, 0.f, 0.f}; }
    const int nfull = (a.nrows / 2) / NGW, rest = a.nrows - 2 * nfull * NGW; const bool single = rest <= NGW;
    const int nit = nfull + (rest > 0 ? (single ? 1 : (rest / 2 + NGW - 1) / NGW) : 0);
#pragma unroll 1
    for (int it = 0; it < nit; ++it) {
        const bool tail = it >= nfull; const int mpr = gw + it * NGW;
        const int m0 = (tail && single) ? 2 * nfull * NGW + gw : 2 * mpr, d1 = (tail && single) ? 0 : DM;
        if (tail && (single ? gw >= rest : mpr >= a.nrows / 2)) break;
        const bool isl = m0 < ML; const int rb = isl ? (m0 >> 12) : 8;
        const size_t xoff = isl ? (size_t)m0 * DM : (size_t)(m0 - ML) * DM;
        const void* xrb = isl ? a.xlat : a.xctx; void* xob = isl ? a.olat : a.octx;
        bf16_t* xn = XN + (size_t)m0 * DM;
        const size_t moff = (size_t)rb * NMOD;
        f32x4 v[2][4], y[2][4], gt[4], sh[4], sc[4];
        if (a.xin_f32) {
#pragma unroll
            for (int u = 0; u < 2; ++u)
#pragma unroll
                for (int j = 0; j < 4; ++j) v[u][j] = *(const f32x4*)((const float*)xrb + xoff + u * d1 + 4 * lane + 256 * j);
        } else {
#pragma unroll
            for (int u = 0; u < 2; ++u)
#pragma unroll
                for (int j = 0; j < 4; ++j) { const u32x2 xw = *(const u32x2*)((const bf16_t*)xrb + xoff + u * d1 + 4 * lane + 256 * j); v[u][j] = (f32x4){bf_lo(xw.x), bf_hi(xw.x), bf_lo(xw.y), bf_hi(xw.y)}; }
        }
        if (a.has_y) {
            if (isl || !a.ctx_split) {
#pragma unroll
                for (int u = 0; u < 2; ++u)
#pragma unroll
                    for (int j = 0; j < 4; ++j) { const u32x2 yw = *(const u32x2*)(xn + u * d1 + 4 * lane + 256 * j); y[u][j] = (f32x4){bf_lo(yw.x), bf_hi(yw.x), bf_lo(yw.y), bf_hi(yw.y)}; }
            } else {
                const float* part = (const float*)p.out;
#pragma unroll
                for (int u = 0; u < 2; ++u)
#pragma unroll
                    for (int j = 0; j < 4; ++j) { const float* pp = part + (size_t)(m0 - ML) * DM + u * d1 + 4 * lane + 256 * j; f32x4 s = *(const f32x4*)pp;
#pragma unroll
                        for (int k = 1; k < pg8::KSPLIT; ++k) s += *(const f32x4*)(pp + (size_t)k * MC * DM);
                        y[u][j] = s; }
            }
#pragma unroll
            for (int j = 0; j < 4; ++j) gt[j] = *(const f32x4*)(a.mod_cur + moff + a.gate_off + 4 * lane + 256 * j);
        }
        if (a.write_xn) {
#pragma unroll
            for (int j = 0; j < 4; ++j) { sh[j] = *(const f32x4*)(a.mod_nxt + moff + a.sh_off + 4 * lane + 256 * j); sc[j] = *(const f32x4*)(a.mod_nxt + moff + a.sc_off + 4 * lane + 256 * j); }
        }
        __builtin_amdgcn_sched_barrier(0);
        if (a.has_y) {
#pragma unroll
            for (int u = 0; u < 2; ++u) {
                float s = 0.f;
#pragma unroll
                for (int j = 0; j < 4; ++j) s += (y[u][j][0] * y[u][j][0] + y[u][j][1] * y[u][j][1]) + (y[u][j][2] * y[u][j][2] + y[u][j][3] * y[u][j][3]);
                const float rstd = rsqrtf(wave_sum(s) * (1.f / DM) + EPS);
#pragma unroll
                for (int j = 0; j < 4; ++j) { v[u][j] = v[u][j] + gt[j] * (y[u][j] * rstd * gpo[j]);
                    if (a.xout_f32) *(f32x4*)((float*)xob + xoff + u * d1 + 4 * lane + 256 * j) = v[u][j];
                    else { u32x2 w; w.x = cvt_pk_bf16(v[u][j][0], v[u][j][1]); w.y = cvt_pk_bf16(v[u][j][2], v[u][j][3]); *(u32x2*)((bf16_t*)xob + xoff + u * d1 + 4 * lane + 256 * j) = w;
                        v[u][j] = (f32x4){bf_lo(w.x), bf_hi(w.x), bf_lo(w.y), bf_hi(w.y)}; } } }
        }
        if (a.write_xn) {
#pragma unroll
            for (int u = 0; u < 2; ++u) {
                float s2 = 0.f;
#pragma unroll
                for (int j = 0; j < 4; ++j) s2 += (v[u][j][0] * v[u][j][0] + v[u][j][1] * v[u][j][1]) + (v[u][j][2] * v[u][j][2] + v[u][j][3] * v[u][j][3]);
                const float rstd = rsqrtf(wave_sum(s2) * (1.f / DM) + EPS);
#pragma unroll
                for (int j = 0; j < 4; ++j) { const f32x4 h = (v[u][j] * rstd * gpr[j]) * (sc[j] + 1.f) + sh[j];
                    u32x2 w; w.x = cvt_pk_bf16(h[0], h[1]); w.y = cvt_pk_bf16(h[2], h[3]);
                    *(u32x2*)(xn + u * d1 + 4 * lane + 256 * j) = w; } }
        }
    }
}

constexpr float LOG2E = 1.4426950408889634f;
constexpr int RPB_PITCH = 64, RPB_OFF = 16;

constexpr int AT_KC = 0, AT_VC = 32768;
constexpr int AT_KL = 0, AT_VL = 73728, AT_VLP = 1280, AT_RPB = AT_VL + 64 * AT_VLP;
static_assert(AT_RPB + 15 * 64 * 4 <= LDS_BYTES - 16, "attention LDS map");
__device__ __forceinline__ int kswz(int key) { return ((key >> 1) & 1) | (((key >> 3) & 3) << 1); }

template <bool LOC, int NCH, int C0>
__device__ __forceinline__ void attn_half(const LAS unsigned char* lds, int kaddr0, int kaddr1, int kcs, int vrow, int vchunk0, int vcs, int vpitch_dt,
                                          const LAS float* bp, int elo, const bf16x8 q0, const bf16x8 q1, float& mx, float& lsum, f32x4 (&o)[4], int g, int qi) {
    constexpr float SC = 0.125f * LOG2E;
    float s[NCH][8];
    bf16x8 kf[2][4];
#define AH_LDK(c, bufi) do { kf[bufi][0] = *(const LAS bf16x8*)(lds + kaddr0 + (C0 + (c)) * kcs); kf[bufi][1] = *(const LAS bf16x8*)(lds + kaddr1 + (C0 + (c)) * kcs); \
        kf[bufi][2] = *(const LAS bf16x8*)(lds + kaddr0 + (C0 + (c)) * kcs + 512); kf[bufi][3] = *(const LAS bf16x8*)(lds + kaddr1 + (C0 + (c)) * kcs + 512); } while (0)
    AH_LDK(0, 0);
#pragma unroll
    for (int c = 0; c < NCH; ++c) {
        if (c < NCH - 1) AH_LDK(c + 1, (c + 1) & 1);
        __builtin_amdgcn_sched_barrier(0);
        f32x4 t0 = (f32x4){0.f, 0.f, 0.f, 0.f}, t1 = (f32x4){0.f, 0.f, 0.f, 0.f};
        t0 = __builtin_amdgcn_mfma_f32_16x16x32_bf16(kf[c & 1][0], q0, t0, 0, 0, 0); t1 = __builtin_amdgcn_mfma_f32_16x16x32_bf16(kf[c & 1][2], q0, t1, 0, 0, 0);
        t0 = __builtin_amdgcn_mfma_f32_16x16x32_bf16(kf[c & 1][1], q1, t0, 0, 0, 0); t1 = __builtin_amdgcn_mfma_f32_16x16x32_bf16(kf[c & 1][3], q1, t1, 0, 0, 0);
#pragma unroll
        for (int e = 0; e < 8; ++e) { const float a = (e < 4) ? t0[e] : t1[e - 4];
            if (LOC) { const float bv = bp[(C0 + c) * RPB_PITCH + e]; const bool ok = (e >= elo) && (e < elo + 16); s[c][e] = ok ? (a * SC + bv) : -INFINITY; }
            else s[c][e] = a * SC; }
        __builtin_amdgcn_sched_barrier(0);
    }
#undef AH_LDK
    float m2 = mx;
#pragma unroll
    for (int c = 0; c < NCH; ++c)
#pragma unroll
        for (int e = 0; e < 8; ++e) m2 = fmaxf(m2, s[c][e]);
    m2 = fmaxf(m2, __shfl_xor(m2, 16)); m2 = fmaxf(m2, __shfl_xor(m2, 32));
    const float alpha = __builtin_amdgcn_exp2f(mx - m2);
    mx = m2; lsum *= alpha;
#pragma unroll
    for (int dt = 0; dt < 4; ++dt) o[dt] = o[dt] * alpha;
    bf16x8 vf[2][4];
#define AH_LDV(c, bufi) do { const int vaddr = vrow + (((vchunk0 + (C0 + (c)) * vcs + g) ^ qi) << 4); _Pragma("unroll") for (int dt = 0; dt < 4; ++dt) vf[bufi][dt] = *(const LAS bf16x8*)(lds + vaddr + dt * vpitch_dt); } while (0)
    AH_LDV(0, 0);
#pragma unroll
    for (int c = 0; c < NCH; ++c) {
        if (c < NCH - 1) AH_LDV(c + 1, (c + 1) & 1);
        __builtin_amdgcn_sched_barrier(0);
        float pe[8];
#pragma unroll
        for (int e = 0; e < 8; ++e) { pe[e] = __builtin_amdgcn_exp2f(s[c][e] - mx); lsum += pe[e]; }
        u32x4 pw; pw.x = cvt_pk_bf16(pe[0], pe[1]); pw.y = cvt_pk_bf16(pe[2], pe[3]); pw.z = cvt_pk_bf16(pe[4], pe[5]); pw.w = cvt_pk_bf16(pe[6], pe[7]);
        const bf16x8 pb = __builtin_bit_cast(bf16x8, pw);
#pragma unroll
        for (int dt = 0; dt < 4; ++dt) o[dt] = __builtin_amdgcn_mfma_f32_16x16x32_bf16(vf[c & 1][dt], pb, o[dt], 0, 0, 0);
        __builtin_amdgcn_sched_barrier(0);
    }
#undef AH_LDV
}

__device__ __forceinline__ void attn_store(bf16_t* MIX, int qtok, int h, int g, float lsum, const f32x4 (&o)[4]) {
    lsum += __shfl_xor(lsum, 16); lsum += __shfl_xor(lsum, 32);
    const float inv = 1.f / lsum;
    bf16_t* op = MIX + (size_t)qtok * DM + 512 + h * 64 + 4 * g;
#pragma unroll
    for (int dt = 0; dt < 4; ++dt) { u32x2 w; w.x = cvt_pk_bf16(o[dt][0] * inv, o[dt][1] * inv); w.y = cvt_pk_bf16(o[dt][2] * inv, o[dt][3] * inv); *(u32x2*)(op + 16 * dt) = w; }
}

__device__ __forceinline__ void phase_mixer(const Params& p, LAS unsigned char* lds, int l, bool with_ctx, int G, int tid, int wave, int lane, int rep_attn, int rep_pool) {
    const bf16_t* PB = (const bf16_t*)(p.ws + WS_PB); const bf16_t* VT = (const bf16_t*)(p.ws + WS_VT); bf16_t* MIX = (bf16_t*)(p.ws + WS_MIX);
    const int gw = blockIdx.x * NWAVES + wave, NGW = G * NWAVES;
    const int qi = lane & 15, g = lane >> 4, kap = 8 * (qi >> 2) + (qi & 3);
#pragma unroll 1
    for (int ra = 0; ra < rep_attn; ++ra)
#pragma unroll 1
    for (int I = blockIdx.x; I < 64 * 32; I += G) {
        const int x = I & 7, t = I >> 3, j = t & 31, rho = t >> 5, pr = rho * 8 + x, b = pr >> 3, h = pr & 7;
        const int r0 = 2 * j, rs0 = min(max(r0 - 4, 0), 56);
        const int r = r0 + (wave >> 2), n = wave & 3, rs = min(max(r - 4, 0), 56), kc0 = min(max(16 * n - 8, 0), 32);
        const int qc = 16 * n + qi, qs = min(max(qc - 8, 0), 48);
        const int sel = (j - 2 * rho) & 31;
        const int npass = (with_ctx && sel < 2) ? 2 : 1;
        {
            u32x4 kreg[4], vreg[4];
            const bf16_t* ksrc = PB + (size_t)(ML + b * CT + (tid >> 3)) * PBW + 1024 + h * 64 + (tid & 7) * 8;
            const bf16_t* vsrc = VT + (size_t)(h * 64 + (tid >> 5)) * VTP + ML + b * CT + (tid & 31) * 8;
#pragma unroll
            for (int ps = 0; ps < 4; ++ps) { kreg[ps] = *(const u32x4*)(ksrc + (size_t)(ps * 64) * PBW); vreg[ps] = *(const u32x4*)(vsrc + (size_t)(ps * 16) * VTP); }
            __builtin_amdgcn_sched_barrier(0);
#pragma unroll
            for (int ps = 0; ps < 4; ++ps) { const int key = ps * 64 + (tid >> 3), d = ps * 16 + (tid >> 5);
                *(LAS u32x4*)(lds + AT_KC + key * 128 + ((((tid & 7) ^ kswz(key))) << 4)) = kreg[ps];
                *(LAS u32x4*)(lds + AT_VC + d * 512 + ((((tid & 31) ^ (d & 15))) << 4)) = vreg[ps]; }
        }
        __syncthreads();
        float mxA = -INFINITY, lA = 0.f; f32x4 oA[4]; bf16x8 qA0, qA1;
        {
            const int kl = kap, ka0 = AT_KC + kl * 128 + ((g ^ kswz(kl)) << 4), ka1 = AT_KC + kl * 128 + (((g + 4) ^ kswz(kl)) << 4);
            const int vrow = AT_VC + qi * 512;
#pragma unroll 1
            for (int ps = 0; ps < npass; ++ps) {
                const int qtok = (ps == 0) ? (b * SEQ + r * 64 + 16 * n + qi) : (ML + b * CT + 16 * (sel * 8 + wave) + qi);
                const bf16_t* qp = PB + (size_t)qtok * PBW + 512 + h * 64 + 8 * g;
                const bf16x8 q0 = *(const bf16x8*)qp, q1 = *(const bf16x8*)(qp + 32);
                float mx = -INFINITY, ls = 0.f; f32x4 o[4];
#pragma unroll
                for (int dt = 0; dt < 4; ++dt) o[dt] = (f32x4){0.f, 0.f, 0.f, 0.f};
                attn_half<false, 4, 0>(lds, ka0, ka1, 32 * 128, vrow, 0, 4, 16 * 512, nullptr, 0, q0, q1, mx, ls, o, g, qi);
                attn_half<false, 4, 4>(lds, ka0, ka1, 32 * 128, vrow, 0, 4, 16 * 512, nullptr, 0, q0, q1, mx, ls, o, g, qi);
                if (ps == 0) { mxA = mx; lA = ls; qA0 = q0; qA1 = q1;
#pragma unroll
                    for (int dt = 0; dt < 4; ++dt) oA[dt] = o[dt]; }
                else attn_store(MIX, qtok, h, g, ls, o);
            }
        }
        __syncthreads();
        {
            const int tok0 = b * SEQ + rs0 * 64;
            const bf16_t* ksrc = PB + (size_t)(tok0 + (tid >> 3)) * PBW + 1024 + h * 64 + (tid & 7) * 8;
            u32x4 kreg[9], vreg[9];
#pragma unroll
            for (int ps = 0; ps < 9; ++ps) { const int idx = ps * 512 + tid, d = idx / 72, ch = idx - d * 72;
                kreg[ps] = *(const u32x4*)(ksrc + (size_t)(ps * 64) * PBW);
                vreg[ps] = *(const u32x4*)(VT + (size_t)(h * 64 + d) * VTP + tok0 + ch * 8); }
            __builtin_amdgcn_sched_barrier(0);
#pragma unroll
            for (int ps = 0; ps < 9; ++ps) { const int key = ps * 64 + (tid >> 3), idx = ps * 512 + tid, d = idx / 72, ch = idx - d * 72;
                *(LAS u32x4*)(lds + AT_KL + key * 128 + ((((tid & 7) ^ kswz(key))) << 4)) = kreg[ps];
                *(LAS u32x4*)(lds + AT_VL + d * AT_VLP + ((ch ^ (d & 15)) << 4)) = vreg[ps]; }
            LAS float* rp = (LAS float*)(lds + AT_RPB);
            for (int i = tid; i < 15 * RPB_PITCH; i += NTHR) { const int row = i >> 6, cc = (i & 63) - RPB_OFF; rp[i] = (cc >= 0 && cc < 31) ? p.in[I_RPB][(size_t)(l * 8 + h) * 15 * 31 + row * 31 + cc] * LOG2E : 0.f; }
        }
        __syncthreads();
        {
            const int kl = (rs - rs0) * 64 + kc0 + kap, ka0 = AT_KL + kl * 128 + ((g ^ kswz(kl)) << 4), ka1 = AT_KL + kl * 128 + (((g + 4) ^ kswz(kl)) << 4);
            const int vrow = AT_VL + qi * AT_VLP, vch0 = (rs - rs0) * 8 + (kc0 >> 3);
            const LAS float* bp = (const LAS float*)(lds + AT_RPB) + (rs - r + 7) * RPB_PITCH + RPB_OFF + (kc0 + 8 * g - qc + 15);
            attn_half<true, 4, 0>(lds, ka0, ka1, 64 * 128, vrow, vch0, 8, 16 * AT_VLP, bp, qs - kc0 - 8 * g, qA0, qA1, mxA, lA, oA, g, qi);
            attn_half<true, 4, 4>(lds, ka0, ka1, 64 * 128, vrow, vch0, 8, 16 * AT_VLP, bp, qs - kc0 - 8 * g, qA0, qA1, mxA, lA, oA, g, qi);
            attn_store(MIX, b * SEQ + r * 64 + 16 * n + qi, h, g, lA, oA);
        }
        __syncthreads();
    }
    const int nrun = (with_ctx ? MT : ML) / 16;
    const int grp = lane >> 4, lo = 1 << grp, hi = lo - 1;
#pragma unroll 1
    for (int rp = 0; rp < rep_pool; ++rp)
#pragma unroll 1
    for (int run = gw; run < nrun; run += NGW) {
        const int tok0 = run * 16; const bool isl = tok0 < ML;
        const int base = isl ? (tok0 & ~(SEQ - 1)) : (ML + ((tok0 - ML) & ~(CT - 1))), len = isl ? SEQ : CT, t0 = tok0 - base;
        u32x4 w[31];
#pragma unroll
        for (int i = 0; i < 31; ++i) { const int tt = min(max(t0 - 8 + i, 0), len - 1); w[i] = *(const u32x4*)(PB + (size_t)(base + tt) * PBW + 8 * lane); }
#pragma unroll
        for (int o = 0; o < 16; ++o) {
            const int t = t0 + o, st = max(t - lo, 0), en = min(t + hi + 1, len);
            float acc[8];
#pragma unroll
            for (int e = 0; e < 8; ++e) acc[e] = 0.f;
#pragma unroll
            for (int i = 0; i < 16; ++i) { const int tt = t + i - 8; const float wt = (tt >= st && tt < en) ? 1.f : 0.f; const u32x4 ww = w[o + i];
                acc[0] += wt * bf_lo(ww.x); acc[1] += wt * bf_hi(ww.x); acc[2] += wt * bf_lo(ww.y); acc[3] += wt * bf_hi(ww.y);
                acc[4] += wt * bf_lo(ww.z); acc[5] += wt * bf_hi(ww.z); acc[6] += wt * bf_lo(ww.w); acc[7] += wt * bf_hi(ww.w); }
            const float ic = 1.f / (float)(en - st);
            const u32x4 sw = w[o + 8];
            u32x4 ov; ov.x = cvt_pk_bf16(acc[0] * ic - bf_lo(sw.x), acc[1] * ic - bf_hi(sw.x)); ov.y = cvt_pk_bf16(acc[2] * ic - bf_lo(sw.y), acc[3] * ic - bf_hi(sw.y));
            ov.z = cvt_pk_bf16(acc[4] * ic - bf_lo(sw.z), acc[5] * ic - bf_hi(sw.z)); ov.w = cvt_pk_bf16(acc[6] * ic - bf_lo(sw.w), acc[7] * ic - bf_hi(sw.w));
            *(u32x4*)(MIX + (size_t)(tok0 + o) * DM + 8 * lane) = ov;
        }
    }
    __syncthreads();
}

constexpr int NPHASE = 2 + 7 * DEPTH;
__global__ void __launch_bounds__(NTHR) fwd_kernel(Params p) {
    extern __shared__ __attribute__((aligned(16))) unsigned char lds_raw[];
    LAS unsigned char* lds = (LAS unsigned char*)lds_raw;
    const int G = gridDim.x;
    const int ph_hi = p.ph_hi;
    volatile LAS unsigned* xst = (volatile LAS unsigned*)(lds + LDS_BYTES - 16);
    if (threadIdx.x < 4) xst[threadIdx.x] = 0u;
    unsigned* const xbar = (unsigned*)(p.ws + WS_BAR);
    if (blockIdx.x == 0) for (int i = threadIdx.x; i < XCD_BAR_WORDS; i += NTHR) __hip_atomic_store(&xbar[i], 0u, __ATOMIC_RELAXED, __HIP_MEMORY_SCOPE_AGENT);
    __syncthreads();
    XcdBarrier xb; xb.bar = xbar; xb.x = 0; xb.st = xst;
    bool xb_posted = false;
    for (int ph = p.ph_lo; ph < ph_hi; ++ph) {
#if PROBE_DUP
        int ptype = -1; if (ph == 0) ptype = 0; else if (ph >= 2) { const int s_ = (ph - 2) % 7; ptype = (s_ == 0) ? 2 : (s_ == 1) ? 1 : (s_ == 2) ? 3 : (s_ == 4) ? 4 : (s_ == 5) ? 5 : -1; }
        const int nrep = (ptype >= 0 && ((PROBE_DUP >> ptype) & 1)) ? 2 : 1;
        for (int rep = 0; rep < nrep; ++rep) {
        if (rep) __syncthreads();
#endif
        int z = 0; asm volatile("s_mov_b32 %0, 0" : "=s"(z));
        Params q;
#pragma unroll
        for (int i = 0; i < 17; ++i) q.in[i] = p.in[i] + z;
        q.out = p.out + z; q.ws = p.ws + z; q.ph_lo = 0; q.ph_hi = 0;
        const int tid = threadIdx.x + z, lane = tid & 63, wave = __builtin_amdgcn_readfirstlane(tid >> 6);
        const float* mod = (const float*)(q.ws + WS_MOD);
        bf16_t* XN = (bf16_t*)(q.ws + WS_XN);
        bf16_t* ctxr = (bf16_t*)(q.ws + WS_CTXR); bf16_t* xres = (bf16_t*)(q.ws + WS_XR);
        if (ph == 0) phase_prologue(q, lds, G, tid, wave, lane);
        else if (ph == 1) {
            RowArgs a{}; a.xlat = q.in[I_X]; a.xctx = q.in[I_CTX]; a.xin_f32 = true; a.nrows = MT; a.has_y = false; a.write_xn = true;
            a.gpre = q.in[I_GPREMIX]; a.mod_nxt = mod; a.sh_off = 0; a.sc_off = DM;
            phase_rows(q, a, G, wave, lane);
        } else {
            const int l = (ph - 2) / 7, s = (ph - 2) % 7; const bool last = (l == DEPTH - 1);
            const int nMrows = last ? ML / 256 : MT / 256;
            if (s == 0) {
                pg8::Gemm g{XN, (const bf16_t*)(q.ws + WS_WIN) + (size_t)l * NIN * DM, DM, 6};
                pg8::StaticOrder S; S.init(MT / 256, 8, G, (int)blockIdx.x);
                pg8::Epi<0> E{(bf16_t*)(q.ws + WS_PB), (bf16_t*)(q.ws + WS_VT), nullptr};
                pg8::gemm_phase<pg8::Epi<0>, true>(lds, g, S, E, tid);
            } else if (s == 1) {
                phase_mixer(q, lds, l, !last, G, tid, wave, lane, 1 + ((PROBE_DUP >> 8) & 1), 1 + ((PROBE_DUP >> 6) & 1));
            } else if (s == 2) {
                pg8::Gemm g{(const bf16_t*)(q.ws + WS_MIX), (const bf16_t*)(q.ws + WS_WOUT) + (size_t)l * DM * DM, DM, 1 << 30};
                pg8::StaticOrder S; S.init(ML / 256, 4, G, (int)blockIdx.x, last ? 0 : MC / 256);
                pg8::Epi<1> E{XN, nullptr, q.out};
                pg8::gemm_phase<pg8::Epi<1>, true>(lds, g, S, E, tid);
            } else if (s == 3) {
                RowArgs a{}; a.xlat = (l == 0) ? (const void*)q.in[I_X] : (const void*)xres; a.xctx = (l == 0) ? (const void*)q.in[I_CTX] : (const void*)ctxr; a.xin_f32 = (l == 0); a.olat = xres; a.octx = ctxr; a.xout_f32 = false;
                a.gpost = q.in[I_GPOSTMIX] + l * DM; a.mod_cur = mod + (size_t)l * 9 * NMOD; a.gate_off = 2 * DM;
                a.gpre = q.in[I_GPREMLP] + l * DM; a.mod_nxt = a.mod_cur; a.sh_off = 3 * DM; a.sc_off = 4 * DM;
                a.nrows = nMrows * 256; a.has_y = true; a.write_xn = true; a.ctx_split = true;
                phase_rows(q, a, G, wave, lane);
            } else if (s == 4) {
                pg8::Gemm g{XN, (const bf16_t*)(q.ws + WS_W1) + (size_t)l * FF * DM, DM, 1 << 30};
                pg8::StaticOrder S; S.init(nMrows, 16, G, (int)blockIdx.x);
                pg8::Epi<2> E{(bf16_t*)(q.ws + WS_H), nullptr, nullptr};
                pg8::gemm_phase<pg8::Epi<2>, true>(lds, g, S, E, tid);
            } else if (s == 5) {
                pg8::Gemm g{(const bf16_t*)(q.ws + WS_H), (const bf16_t*)(q.ws + WS_W2) + (size_t)l * DM * FF, FF, 1 << 30};
                pg8::StaticOrder S; S.init(ML / 256, 4, G, (int)blockIdx.x, last ? 0 : MC / 256);
                pg8::Epi<1> E{XN, nullptr, q.out};
                pg8::gemm_phase<pg8::Epi<1>, true>(lds, g, S, E, tid);
            } else {
                RowArgs a{}; a.xlat = xres; a.xctx = ctxr; a.xin_f32 = false; a.olat = last ? (void*)q.out : (void*)xres; a.octx = ctxr; a.xout_f32 = last;
                a.gpost = q.in[I_GPOSTMLP] + l * DM; a.mod_cur = mod + (size_t)l * 9 * NMOD; a.gate_off = 5 * DM;
                a.nrows = nMrows * 256; a.has_y = true; a.write_xn = !last; a.ctx_split = true;
                if (!last) { a.gpre = q.in[I_GPREMIX] + (l + 1) * DM; a.mod_nxt = mod + (size_t)(l + 1) * 9 * NMOD; a.sh_off = 0; a.sc_off = DM; }
                phase_rows(q, a, G, wave, lane);
            }
        }
#if PROBE_DUP
        }
#endif
        if (ph + 1 < ph_hi) {
            if (!xb_posted) { cg::this_grid().sync(); xb = xcd_barrier_post(xbar, xst); xb_posted = true; }
            else { xcd_barrier(xb); if (PROBE_DUP & 128) xcd_barrier(xb); }
        }
    }
}

extern "C" void kernel_launch(void* const* d_in, const int* in_sizes, int n_in, void* d_out, int out_size, void* d_ws, size_t ws_size, hipStream_t stream) {
    static int grid = 0;
    if (grid == 0) {
        if (n_in != 17 || in_sizes[0] != ML * DM || out_size != ML * DM || ws_size < WS_END) { fprintf(stderr, "kernel_launch: unexpected shapes (n_in %d, in0 %d, out %d, ws %zu)\n", n_in, n_in > 0 ? in_sizes[0] : -1, out_size, ws_size); grid = -1; return; }
        int dev = 0, cus = 0, per_cu = 0;
        (void)hipGetDevice(&dev);
        (void)hipDeviceGetAttribute(&cus, hipDeviceAttributeMultiprocessorCount, dev);
        if (hipFuncSetAttribute((const void*)fwd_kernel, hipFuncAttributeMaxDynamicSharedMemorySize, LDS_BYTES) != hipSuccess) { fprintf(stderr, "kernel_launch: hipFuncSetAttribute failed\n"); grid = -1; return; }
        if (hipOccupancyMaxActiveBlocksPerMultiprocessor(&per_cu, (const void*)fwd_kernel, NTHR, LDS_BYTES) != hipSuccess || per_cu < 1) { fprintf(stderr, "kernel_launch: occupancy query says %d\n", per_cu); per_cu = 1; }
        (void)hipGetLastError();
        grid = cus * 1;
    }
    if (grid < 0) return;
    Params p{};
    for (int i = 0; i < 17; ++i) p.in[i] = (const float*)d_in[i];
    p.out = (float*)d_out; p.ws = (unsigned char*)d_ws;
#if MK_SPLIT
    for (int ph = 0; ph < NPHASE; ++ph) { p.ph_lo = ph; p.ph_hi = ph + 1; hipLaunchKernelGGL(fwd_kernel, dim3(grid), dim3(NTHR), LDS_BYTES, stream, p); }
#else
    p.ph_lo = 0; p.ph_hi = NPHASE;
    void* args[] = {&p};
    hipError_t e = hipLaunchCooperativeKernel((const void*)fwd_kernel, dim3(grid), dim3(NTHR), args, LDS_BYTES, stream);
    if (e != hipSuccess) fprintf(stderr, "cooperative launch failed: %s (grid %d)\n", hipGetErrorString(e), grid);
#endif
}
```

```cpp
#include <hip/hip_runtime.h>
#include <hip/hip_cooperative_groups.h>
#include <cstdio>
#include <cstdint>
namespace cg = cooperative_groups;

#ifndef MK_SPLIT
#define MK_SPLIT 0
#endif

#ifndef PROBE_DUP
#define PROBE_DUP 0
#endif
#define LAS __attribute__((address_space(3)))
typedef unsigned short bf16_t;
typedef short bf16x8 __attribute__((ext_vector_type(8)));
typedef float f32x4 __attribute__((ext_vector_type(4)));
typedef float f32x2 __attribute__((ext_vector_type(2)));
typedef unsigned u32x4 __attribute__((ext_vector_type(4)));
typedef unsigned u32x2 __attribute__((ext_vector_type(2)));

constexpr int DM = 1024, NB = 8, SEQ = 4096, CT = 256, DEPTH = 4, FF = 4096, NIN = 2048;
constexpr int ML = NB * SEQ, MC = NB * CT, MT = ML + MC;
constexpr int NMOD = 6 * DM;
constexpr int VTP = MT + 128;
constexpr int PBW = 1536;
constexpr float EPS = 1e-6f;
constexpr int NWAVES = 8, NTHR = 512;

constexpr size_t MiB = 1u << 20;
constexpr size_t WS_MOD = 0;
constexpr size_t WS_SS = 1 * MiB;
constexpr size_t WS_BAR = 3 * MiB + 512 * 1024;
constexpr size_t WS_CTXR = 4 * MiB;
constexpr size_t WS_WIN = 12 * MiB;
constexpr size_t WS_WOUT = 28 * MiB;
constexpr size_t WS_W1 = 36 * MiB;
constexpr size_t WS_W2 = 68 * MiB;
constexpr size_t WS_XN = 100 * MiB;
constexpr size_t WS_H = 168 * MiB;
constexpr size_t WS_PB = WS_H;
constexpr size_t WS_VT = 270 * MiB;
constexpr size_t WS_MIX = 306 * MiB;
constexpr size_t WS_XR = 440 * MiB;
constexpr size_t WS_END = 504 * MiB;
static_assert(WS_PB + (size_t)MT * PBW * 2 <= WS_VT && WS_VT + (size_t)512 * VTP * 2 <= WS_MIX && WS_MIX + (size_t)MT * DM * 2 <= WS_END, "ws");
static_assert(WS_H + (size_t)MT * FF * 2 <= WS_XR && WS_XR + (size_t)ML * DM * 2 <= WS_END && (size_t)8 * MC * DM * 4 <= (size_t)ML * DM * 4, "ws h");

constexpr int LDS_BYTES = 163840;

typedef __bf16 bf16v2 __attribute__((ext_vector_type(2)));
__device__ __forceinline__ unsigned cvt_pk_bf16(float lo, float hi) { const f32x2 v = (f32x2){lo, hi}; return __builtin_bit_cast(unsigned, __builtin_convertvector(v, bf16v2)); }
__device__ __forceinline__ float bf_lo(unsigned w) { return __uint_as_float(w << 16); }
__device__ __forceinline__ float bf_hi(unsigned w) { return __uint_as_float(w & 0xffff0000u); }
__device__ __forceinline__ float wave_sum(float v) {
#pragma unroll
    for (int o = 1; o < 64; o <<= 1) v += __shfl_xor(v, o);
    return v;
}
#define LDS_WAIT() asm volatile("s_waitcnt lgkmcnt(0)" ::: "memory")

namespace pg8 {
constexpr int BM = 256, BK = 64, HALF = 128, HTB = HALF * BK * 2, STAGE_BYTES = 8 * HTB, NXCD = 8, WGM = 8;
__host__ __device__ __forceinline__ int lds_byte(int r, int c) { const int st = (r >> 4) * 2 + (c >> 5), rr = r & 15, cc = c & 31, ob = rr * 64 + cc * 2; return st * 1024 + (ob ^ (((ob >> 9) & 1) << 5)); }
__host__ __device__ __forceinline__ void stage_rc(int b, int& R, int& C) { const int st = b / 1024, sb = b % 1024, swz = sb ^ (((sb >> 9) & 1) << 5); R = (st >> 1) * 16 + swz / 64; C = (st & 1) * 32 + (swz % 64) / 2; }
__host__ __device__ __forceinline__ int perm32(int rho) { const int n = rho >> 4, i = rho & 15; return 8 * (i >> 2) + 4 * n + (i & 3); }

struct Unit { int pm, pn, ks; };
constexpr int KSPLIT = 8;
struct Gemm { const bf16_t* A; const bf16_t* Bt; int K; int nN_main; };

struct StaticOrder {
    int nM, nN, nwg, G, c, nsplit;
    __device__ __forceinline__ void init(int nM_, int nN_, int G_, int c_, int nsplit_ = 0) { nM = nM_; nN = nN_; nwg = nM * nN; G = G_; c = c_; nsplit = nsplit_; }
    __device__ __forceinline__ bool next(int i, Unit& u) const {
        const long L = (long)i * G + c; if (L >= nwg + nsplit * nN * KSPLIT) return false;
        int pm, pn, ks;
        if (L >= nwg) { const int e = (int)L - nwg, cu = e / KSPLIT; ks = e % KSPLIT; pm = nM + cu / nN; pn = cu % nN; }
        else {
            int wgid = (int)L; { const int q = nwg / NXCD, r = nwg % NXCD, xcd = wgid % NXCD, off = wgid / NXCD; wgid = (xcd < r ? xcd * (q + 1) : r * (q + 1) + (xcd - r) * q) + off; }
            const int nig = WGM * nN, gid = wgid / nig, fm = gid * WGM, gsz = (nM - fm) < WGM ? (nM - fm) : WGM;
            pm = fm + ((wgid % nig) % gsz); pn = (wgid % nig) / gsz; ks = -1;
        }
        u.pm = pm; u.pn = pn; u.ks = ks; return true;
    }
};

template <int MODE> struct Epi {
    bf16_t* O; bf16_t* O2; float* part;
    __device__ __forceinline__ void operator()(const f32x4 (&acc)[2][2][4][2], const Unit& u, int wr, int wc, int fr, int fq) const {
        int prow = u.pm, pcol = u.pn; bf16_t* base = O; size_t ldc = (MODE == 0) ? PBW : (MODE == 1 ? DM : FF);
        if (MODE == 0 && u.pn >= 6) { prow = u.pn - 6; pcol = u.pm; base = O2; ldc = VTP; }
        const int row0 = prow * BM + wr * 64 + fr, col0 = pcol * BM + wc * 32 + 8 * fq;
        if (MODE == 1 && u.ks >= 0) {
            float* pb = part + ((size_t)u.ks * MC + (size_t)(row0 - ML)) * DM + col0;
#pragma unroll
            for (int ai = 0; ai < 2; ++ai)
#pragma unroll
                for (int m = 0; m < 4; ++m) { float* rowp = pb + (size_t)(ai * HALF + m * 16) * DM;
#pragma unroll
                    for (int bj = 0; bj < 2; ++bj) { *(f32x4*)(rowp + bj * HALF) = acc[ai][bj][m][0]; *(f32x4*)(rowp + bj * HALF + 4) = acc[ai][bj][m][1]; } }
            return;
        }
#pragma unroll
        for (int ai = 0; ai < 2; ++ai)
#pragma unroll
            for (int m = 0; m < 4; ++m) { bf16_t* rowp = base + (size_t)(row0 + ai * HALF + m * 16) * ldc + col0;
#pragma unroll
                for (int bj = 0; bj < 2; ++bj) { f32x4 v0 = acc[ai][bj][m][0], v1 = acc[ai][bj][m][1];
                    if (MODE == 2) {
#pragma unroll
                        for (int e = 0; e < 4; ++e) { const float a = fmaxf(v0[e], 0.f), b = fmaxf(v1[e], 0.f); v0[e] = a * a; v1[e] = b * b; } }
                    u32x4 w; w.x = cvt_pk_bf16(v0[0], v0[1]); w.y = cvt_pk_bf16(v0[2], v0[3]); w.z = cvt_pk_bf16(v1[0], v1[1]); w.w = cvt_pk_bf16(v1[2], v1[3]);
                    *(u32x4*)(rowp + bj * HALF) = w; } }
    }
};

template <class EpiT, bool ALIGN_EPI>
__device__ __forceinline__ void gemm_phase(LAS unsigned char* lds, const Gemm g, const StaticOrder& S, const EpiT& E, const int tid) {
    const int wid = __builtin_amdgcn_readfirstlane(tid >> 6), lane = tid & 63, wr = wid >> 2, wc = wid & 3, fr = lane & 15, fq = lane >> 4;
    const int K = g.K;
    unsigned voffA[2], voffB[2];
#pragma unroll
    for (int i = 0; i < 2; ++i) { int R, C; stage_rc(tid * 16 + i * 8192, R, C); const int Rb = (R & ~31) + perm32(R & 31);
        voffA[i] = (unsigned)(R * K + C) * 2u; voffB[i] = (unsigned)(Rb * K + C) * 2u; }
    const size_t kstep = (size_t)(BK * 2);
    const size_t hstep = (size_t)HALF * K * 2;
    const size_t tstep = 2 * hstep;
    const unsigned ldsw = (unsigned)wid * 1024u;
    const int aoff = lds_byte(wr * 64 + fr, fq * 8), boff = lds_byte(wc * 32 + fr, fq * 8);
#define PG8_SA(b, h) (((b) * 2 + (h)) * HTB)
#define PG8_SB(b, h) ((4 + (b) * 2 + (h)) * HTB)
#define PG8_STAGE(bufoff, gbase, voff) do { _Pragma("unroll") for (int _i = 0; _i < 2; ++_i) \
        __builtin_amdgcn_global_load_lds((const unsigned*)((const char*)(gbase) + (voff)[_i]), (LAS unsigned*)(lds + (bufoff) + ldsw + _i * 8192), 16, 0, 0); } while (0)
#define PG8_LDA(dst, b, h) do { _Pragma("unroll") for (int m = 0; m < 4; ++m) _Pragma("unroll") for (int k = 0; k < 2; ++k) dst[m][k] = *(const LAS bf16x8*)(lds + PG8_SA(b, h) + aoff + m * 2048 + k * 1024); } while (0)
#define PG8_LDB(dst, b, h) do { _Pragma("unroll") for (int n = 0; n < 2; ++n) _Pragma("unroll") for (int k = 0; k < 2; ++k) dst[n][k] = *(const LAS bf16x8*)(lds + PG8_SB(b, h) + boff + n * 2048 + k * 1024); } while (0)
#define PG8_MMA(ai, bj, At, Bt) do { __builtin_amdgcn_s_setprio(1); _Pragma("unroll") for (int m = 0; m < 4; ++m) _Pragma("unroll") for (int n = 0; n < 2; ++n) _Pragma("unroll") for (int k = 0; k < 2; ++k) \
        acc[ai][bj][m][n] = __builtin_amdgcn_mfma_f32_16x16x32_bf16(Bt[n][k], At[m][k], acc[ai][bj][m][n], 0, 0, 0); __builtin_amdgcn_s_setprio(0); } while (0)
#define PG8_WAIT_V(n) asm volatile("s_waitcnt vmcnt(" #n ")" ::: "memory")
#define PG8_WAIT_L(n) asm volatile("s_waitcnt lgkmcnt(" #n ")" ::: "memory")
#define PG8_BAR __builtin_amdgcn_s_barrier()
#define PG8_SCHED __builtin_amdgcn_sched_barrier(0)
#define PG8_PTRS(u, pa, pb) do { const size_t _ko = (u).ks >= 0 ? (size_t)(u).ks * (size_t)(K / KSPLIT) * 2 : 0; \
        const char* _a = (const char*)g.A + (size_t)(u).pm * tstep + _ko; const char* _b = (const char*)g.Bt + (size_t)(u).pn * tstep + _ko; \
        if ((u).pn >= g.nN_main) { pa = _b; pb = _a; } else { pa = _a; pb = _b; } } while (0)
    Unit cur, nxt; int ui = 0;
    if (!S.next(0, cur)) return;
    f32x4 acc[2][2][4][2];
#pragma unroll
    for (int a = 0; a < 2; ++a)
#pragma unroll
        for (int b = 0; b < 2; ++b)
#pragma unroll
            for (int m = 0; m < 4; ++m)
#pragma unroll
                for (int n = 0; n < 2; ++n) acc[a][b][m][n] = (f32x4){0.f, 0.f, 0.f, 0.f};
    bf16x8 At[4][2], B0[2][2], B1[2][2];
    const char* cA; const char* cB; PG8_PTRS(cur, cA, cB);
    PG8_STAGE(PG8_SB(0, 0), cB, voffB); PG8_STAGE(PG8_SB(0, 1), cB + hstep, voffB); PG8_STAGE(PG8_SA(0, 0), cA, voffA); PG8_STAGE(PG8_SA(0, 1), cA + hstep, voffA);
    if (wr == 1) PG8_BAR;
    PG8_WAIT_V(2); PG8_BAR;
    PG8_STAGE(PG8_SB(1, 0), cB + kstep, voffB); PG8_STAGE(PG8_SA(1, 0), cA + kstep, voffA); PG8_STAGE(PG8_SB(1, 1), cB + hstep + kstep, voffB);
    PG8_WAIT_V(6); PG8_BAR;
    for (;;) {
        const bool has_next = S.next(ui + 1, nxt);
        const char* nA = cA; const char* nB = cB; if (has_next) PG8_PTRS(nxt, nA, nB);
        const int nt = (cur.ks >= 0) ? (K / KSPLIT) / BK : K / BK;
        for (int t = 0; t < nt; t += 2) {
            const bool last = (t == nt - 2);
            const char* a1 = cA + (size_t)(t + 1) * kstep;
            const char* a2 = last ? nA : cA + (size_t)(t + 2) * kstep; const char* b2 = last ? nB : cB + (size_t)(t + 2) * kstep;
            const char* a3 = a2 + kstep; const char* b3 = b2 + kstep;
            PG8_LDB(B0, 0, 0); PG8_LDB(B1, 0, 1); PG8_SCHED; PG8_LDA(At, 0, 0); PG8_STAGE(PG8_SA(1, 1), a1 + hstep, voffA);
            PG8_WAIT_V(8); PG8_WAIT_L(0); PG8_BAR; PG8_MMA(0, 0, At, B0); PG8_MMA(0, 1, At, B1); PG8_BAR; PG8_SCHED;
            PG8_LDA(At, 0, 1); PG8_STAGE(PG8_SB(0, 0), b2, voffB); PG8_STAGE(PG8_SB(0, 1), b2 + hstep, voffB); PG8_STAGE(PG8_SA(0, 0), a2, voffA);
            PG8_WAIT_V(8); PG8_WAIT_L(0); PG8_BAR; PG8_MMA(1, 0, At, B0); PG8_MMA(1, 1, At, B1); PG8_BAR; PG8_SCHED;
            PG8_LDB(B0, 1, 0); PG8_LDB(B1, 1, 1); PG8_SCHED; PG8_LDA(At, 1, 0); PG8_STAGE(PG8_SA(0, 1), a2 + hstep, voffA);
            PG8_WAIT_V(8); PG8_WAIT_L(0); PG8_BAR; PG8_MMA(0, 0, At, B0); PG8_MMA(0, 1, At, B1); PG8_BAR; PG8_SCHED;
            PG8_LDA(At, 1, 1); PG8_STAGE(PG8_SB(1, 0), b3, voffB); PG8_STAGE(PG8_SB(1, 1), b3 + hstep, voffB); PG8_STAGE(PG8_SA(1, 0), a3, voffA);
            PG8_WAIT_V(8); PG8_WAIT_L(0); PG8_BAR; PG8_MMA(1, 0, At, B0); PG8_MMA(1, 1, At, B1); PG8_BAR; PG8_SCHED;
        }
        if constexpr (ALIGN_EPI) { if (wr == 0) PG8_BAR; }
        E(acc, cur, wr, wc, fr, fq);
        if (!has_next) break;
#pragma unroll
        for (int a = 0; a < 2; ++a)
#pragma unroll
            for (int b = 0; b < 2; ++b)
#pragma unroll
                for (int m = 0; m < 4; ++m)
#pragma unroll
                    for (int n = 0; n < 2; ++n) acc[a][b][m][n] = (f32x4){0.f, 0.f, 0.f, 0.f};
        cur = nxt; cA = nA; cB = nB; ++ui;
        if constexpr (ALIGN_EPI) { if (wr == 1) PG8_BAR; }
    }
    PG8_WAIT_V(0);
    if constexpr (!ALIGN_EPI) { if (wr == 0) PG8_BAR; }
    PG8_BAR;
#undef PG8_SA
#undef PG8_SB
#undef PG8_STAGE
#undef PG8_LDA
#undef PG8_LDB
#undef PG8_MMA
#undef PG8_WAIT_V
#undef PG8_WAIT_L
#undef PG8_BAR
#undef PG8_SCHED
#undef PG8_PTRS
}
}

#define XB_TMO      128
#define XB_XCNT(j)  (256  + 64 * (j))
#define XB_XSUB(j)  (1280 + 64 * (j))
#define XB_XGEN(j)  (2304 + 64 * (j))
#define XB_TOP      3328
#define XB_TOPGEN   3392
#define XCD_BAR_WORDS 3456
#define XB_SPIN_CAP (1u << 18)
__device__ __forceinline__ unsigned xb_ld(unsigned* p)              { return __hip_atomic_load(p, __ATOMIC_RELAXED, __HIP_MEMORY_SCOPE_AGENT); }
__device__ __forceinline__ unsigned xb_add(unsigned* p, unsigned v) { return __hip_atomic_fetch_add(p, v, __ATOMIC_RELAXED, __HIP_MEMORY_SCOPE_AGENT); }
__device__ __forceinline__ unsigned xb_xcc_id() { return (unsigned)__builtin_amdgcn_s_getreg((3 << 11) | 20) & 0xFu; }
#define XB_SPIN(cond, bar) do { unsigned _sp = 0; while (cond) { __builtin_amdgcn_s_sleep(1); \
    if ((++_sp & 255u) == 0u) { if (xb_ld(&(bar)[XB_TMO])) break; if (_sp > XB_SPIN_CAP) { atomicAdd(&(bar)[XB_TMO], 1u); break; } } } } while (0)
struct XcdBarrier { unsigned* bar; unsigned x; volatile LAS unsigned* st; };
__device__ __forceinline__ XcdBarrier xcd_barrier_post(unsigned* bar, volatile LAS unsigned* st) {
    XcdBarrier b; b.bar = bar; b.x = xb_xcc_id(); b.st = st;
    if (threadIdx.x == 0) (void)xb_add(&bar[XB_XCNT(b.x)], 1u);
    return b;
}
__device__ __forceinline__ void xcd_barrier_complete(unsigned* bar, unsigned x, unsigned& nloc, unsigned& nx) {
    const unsigned G = gridDim.x * gridDim.y * gridDim.z;
    unsigned sum, cnt, mine, sp = 0u;
    for (;;) {
        sum = 0u; cnt = 0u; mine = 0u;
#pragma unroll
        for (unsigned j = 0; j < 16; ++j) { const unsigned c = xb_ld(&bar[XB_XCNT(j)]); sum += c; cnt += (c > 0u) ? 1u : 0u; mine = (j == x) ? c : mine; }
        if (sum == G) break;
        __builtin_amdgcn_s_sleep(1);
        if ((++sp & 255u) == 0u) { if (xb_ld(&bar[XB_TMO])) break; if (sp > XB_SPIN_CAP) { atomicAdd(&bar[XB_TMO], 1u); break; } }
    }
    nloc = mine > 0u ? mine : 1u; nx = cnt > 0u ? cnt : 1u;
}
__device__ __forceinline__ void xcd_barrier(const XcdBarrier& b) {
    asm volatile("s_waitcnt vmcnt(0)" ::: "memory");
    __syncthreads();
    if (threadIdx.x == 0) {
        unsigned* bar = b.bar;
        __builtin_amdgcn_s_waitcnt(0);
        unsigned nloc = b.st[0], nx = b.st[1];
        if (nloc == 0u) { xcd_barrier_complete(bar, b.x, nloc, nx); b.st[0] = nloc; b.st[1] = nx; }
        const unsigned old = xb_add(&bar[XB_XSUB(b.x)], 1u);
        const unsigned gen = old / nloc;
        if (old + 1u == (gen + 1u) * nloc) {
            __builtin_amdgcn_fence(__ATOMIC_RELEASE, "agent");
            asm volatile("s_waitcnt vmcnt(0)" ::: "memory");
            const unsigned og = xb_add(&bar[XB_TOP], 1u);
            const unsigned tg = og / nx;
            if (og + 1u == (tg + 1u) * nx) xb_add(&bar[XB_TOPGEN], 1u);
            else XB_SPIN(xb_ld(&bar[XB_TOPGEN]) == tg, bar);
            __builtin_amdgcn_fence(__ATOMIC_ACQUIRE, "agent");
            xb_add(&bar[XB_XGEN(b.x)], 1u);
            asm volatile("s_waitcnt vmcnt(0)" ::: "memory");
        } else {
            XB_SPIN(xb_ld(&bar[XB_XGEN(b.x)]) == gen, bar);
            __builtin_amdgcn_fence(__ATOMIC_ACQUIRE, "agent");
            asm volatile("s_waitcnt vmcnt(0)" ::: "memory");
        }
    }
    __syncthreads();
}

struct Params {
    const float* in[17];
    float* out; unsigned char* ws;
    int ph_lo, ph_hi;
};
enum { I_X = 0, I_C, I_CTX, I_CCTX, I_WMOD, I_BMOD, I_GPREMIX, I_GPOSTMIX, I_GPREMLP, I_GPOSTMLP, I_WIN, I_POOLW, I_POOLS, I_RPB, I_WOUT, I_W1, I_W2 };

__device__ __forceinline__ void transpose_item(const float* W, int ldw, bf16_t* WT, int ldt, int kofs, int nblk, LAS float* scr, int item, int lane) {
    const int kb = item / nblk, nb = item % nblk, k0 = 64 * kb, n0 = 32 * nb;
#pragma unroll 8
    for (int i = 0; i < 32; ++i) { const int kk = 2 * i + (lane >> 5); scr[kk * 33 + (lane & 31)] = W[(size_t)(k0 + kk) * ldw + n0 + (lane & 31)]; }
    LDS_WAIT(); asm volatile("" ::: "memory");
    const int c = lane & 7;
#pragma unroll
    for (int j = 0; j < 4; ++j) { const int n = (lane >> 3) + 8 * j; const LAS float* s = scr + (8 * c) * 33 + n;
        u32x4 o; o.x = cvt_pk_bf16(s[0 * 33], s[1 * 33]); o.y = cvt_pk_bf16(s[2 * 33], s[3 * 33]); o.z = cvt_pk_bf16(s[4 * 33], s[5 * 33]); o.w = cvt_pk_bf16(s[6 * 33], s[7 * 33]);
        *(u32x4*)(WT + (size_t)(n0 + n) * ldt + kofs + k0 + 8 * c) = o; }
    LDS_WAIT(); asm volatile("" ::: "memory");
}

__device__ __forceinline__ float silu_f(float v) { return v / (1.f + __expf(-v)); }

__device__ __forceinline__ void mod_item(const Params& p, LAS unsigned char* lds, int item, int tid, int wave, int lane) {
    LAS float* sv = (LAS float*)lds;
    LAS float* part = (LAS float*)(lds + 36864);
    const int l = item / 24, j0 = (item % 24) * 256;
    for (int i = tid; i < 9 * 1024; i += NTHR) { const int r = i >> 10, k = i & 1023; const float v = (r < 8) ? p.in[I_C][r * 1024 + k] : p.in[I_CCTX][k]; sv[i] = silu_f(v); }
    __syncthreads();
    f32x4 acc[9];
#pragma unroll
    for (int r = 0; r < 9; ++r) acc[r] = (f32x4){0.f, 0.f, 0.f, 0.f};
    const float* wp = p.in[I_WMOD] + (size_t)l * DM * NMOD + (size_t)(wave * 128) * NMOD + j0 + 4 * lane;
#pragma unroll 1
    for (int k8 = 0; k8 < 128; k8 += 8) {
        f32x4 wv[8];
#pragma unroll
        for (int u = 0; u < 8; ++u) wv[u] = *(const f32x4*)(wp + (size_t)(k8 + u) * NMOD);
#pragma unroll
        for (int u = 0; u < 8; ++u)
#pragma unroll
            for (int r = 0; r < 9; ++r) { const float s = sv[r * 1024 + wave * 128 + k8 + u]; acc[r] += wv[u] * s; }
    }
#pragma unroll
    for (int r = 0; r < 9; ++r) *(LAS f32x4*)(part + (wave * 9 + r) * 256 + 4 * lane) = acc[r];
    __syncthreads();
    float* mod = (float*)(p.ws + WS_MOD) + (size_t)l * 9 * NMOD;
    for (int i = tid; i < 9 * 256; i += NTHR) { const int r = i >> 8, j = i & 255; float s = p.in[I_BMOD][l * NMOD + j0 + j];
#pragma unroll
        for (int w = 0; w < 8; ++w) s += part[(w * 9 + r) * 256 + j];
        mod[r * NMOD + j0 + j] = s; }
    __syncthreads();
}

__device__ __forceinline__ void weff_item(const Params& p, LAS unsigned char* lds, int item, int tid, int wave, int lane) {
    LAS float* pw = (LAS float*)lds;
    LAS float* wo = (LAS float*)(lds + 128 * 129 * 4);
    const int l = item >> 6, g = (item >> 4) & 3, n0 = (item & 15) * 64;
    const float* pwg = p.in[I_POOLW] + ((size_t)l * 4 + g) * 128 * 128;
    for (int i = tid; i < 128 * 128; i += NTHR) pw[(i >> 7) * 129 + (i & 127)] = pwg[i];
    const float* wog = p.in[I_WOUT] + (size_t)l * DM * DM + (size_t)(g * 128) * DM + n0;
    const float* psg = p.in[I_POOLS] + l * 512 + g * 128;
    for (int i = tid; i < 128 * 64; i += NTHR) { const int d = i >> 6, n = i & 63; wo[i] = wog[(size_t)d * DM + n] * psg[d]; }
    __syncthreads();
    float acc[16];
#pragma unroll
    for (int c = 0; c < 16; ++c) acc[c] = 0.f;
    const int n = lane, cb = wave * 16;
#pragma unroll 4
    for (int d = 0; d < 128; ++d) { const float w = wo[d * 64 + n];
#pragma unroll
        for (int c = 0; c < 16; ++c) acc[c] += pw[(cb + c) * 129 + d] * w; }
    bf16_t* dst = (bf16_t*)(p.ws + WS_WOUT) + (size_t)l * DM * DM + (size_t)(n0 + n) * DM + g * 128 + cb;
    u32x4 o0, o1;
    o0.x = cvt_pk_bf16(acc[0], acc[1]); o0.y = cvt_pk_bf16(acc[2], acc[3]); o0.z = cvt_pk_bf16(acc[4], acc[5]); o0.w = cvt_pk_bf16(acc[6], acc[7]);
    o1.x = cvt_pk_bf16(acc[8], acc[9]); o1.y = cvt_pk_bf16(acc[10], acc[11]); o1.z = cvt_pk_bf16(acc[12], acc[13]); o1.w = cvt_pk_bf16(acc[14], acc[15]);
    *(u32x4*)dst = o0; *(u32x4*)(dst + 8) = o1;
    __syncthreads();
}

__device__ __forceinline__ void phase_prologue(const Params& p, LAS unsigned char* lds, int G, int tid, int wave, int lane) {
    for (int it = blockIdx.x; it < DEPTH * 24; it += G) mod_item(p, lds, it, tid, wave, lane);
    for (int it = blockIdx.x; it < DEPTH * 64; it += G) weff_item(p, lds, it, tid, wave, lane);
    LAS float* scr = (LAS float*)(lds + wave * 16384);
    const int gw = blockIdx.x * NWAVES + wave, NGW = G * NWAVES;
    constexpr int I_IN = 16 * 64, I_O = 8 * 32, I_1 = 16 * 128, I_2 = 64 * 32, I_L = I_IN + I_O + I_1 + I_2;
    for (int it = gw; it < DEPTH * I_L; it += NGW) {
        const int l = it / I_L; int r = it % I_L;
        if (r < I_IN) { transpose_item(p.in[I_WIN] + (size_t)l * DM * NIN, NIN, (bf16_t*)(p.ws + WS_WIN) + (size_t)l * NIN * DM, DM, 0, NIN / 32, scr, r, lane); continue; } r -= I_IN;
        if (r < I_O) { transpose_item(p.in[I_WOUT] + (size_t)l * DM * DM + (size_t)512 * DM, DM, (bf16_t*)(p.ws + WS_WOUT) + (size_t)l * DM * DM, DM, 512, DM / 32, scr, r, lane); continue; } r -= I_O;
        if (r < I_1) { transpose_item(p.in[I_W1] + (size_t)l * DM * FF, FF, (bf16_t*)(p.ws + WS_W1) + (size_t)l * FF * DM, DM, 0, FF / 32, scr, r, lane); continue; } r -= I_1;
        transpose_item(p.in[I_W2] + (size_t)l * FF * DM, DM, (bf16_t*)(p.ws + WS_W2) + (size_t)l * DM * FF, FF, 0, DM / 32, scr, r, lane);
    }
}

struct RowArgs {
    const void* xlat; const void* xctx; bool xin_f32;
    void* olat; void* octx; bool xout_f32;
    const float* gpost; const float* mod_cur;
    int gate_off;
    const float* gpre; const float* mod_nxt; int sh_off, sc_off;
    int nrows; bool has_y, write_xn, ctx_split;
};
__device__ __forceinline__ f32x4 bfx4_lo(u32x4 w) { return (f32x4){bf_lo(w.x), bf_hi(w.x), bf_lo(w.y), bf_hi(w.y)}; }
__device__ __forceinline__ f32x4 bfx4_hi(u32x4 w) { return (f32x4){bf_lo(w.z), bf_hi(w.z), bf_lo(w.w), bf_hi(w.w)}; }
__device__ __forceinline__ void phase_rows(const Params& p, const RowArgs& a, int G, int wave, int lane) {
    bf16_t* XN = (bf16_t*)(p.ws + WS_XN);
    const int gw = blockIdx.x * NWAVES + wave, NGW = G * NWAVES;
    f32x4 gpo[4], gpr[4];
#pragma unroll
    for (int j = 0; j < 4; ++j) { const int c = 8 * lane + 512 * (j >> 1) + 4 * (j & 1);
        gpo[j] = a.has_y ? *(const f32x4*)(a.gpost + c) : (f32x4){0.f, 0.f, 0.f, 0.f};
        gpr[j] = a.write_xn ? *(const f32x4*)(a.gpre + c) : (f32x4){0.f, 0.f, 0.f, 0.f}; }
#pragma unroll 1
    for (int mp = gw; mp < a.nrows / 2; mp += NGW) {
        const int m0 = 2 * mp; const bool isl = m0 < ML; const int rb = isl ? (m0 >> 12) : 8;
        const size_t xoff = isl ? (size_t)m0 * DM : (size_t)(m0 - ML) * DM;
        const void* xrb = isl ? a.xlat : a.xctx; void* xob = isl ? a.olat : a.octx;
        bf16_t* xn = XN + (size_t)m0 * DM;
        const size_t moff = (size_t)rb * NMOD;
        f32x4 v[2][4], y[2][4], gt[4], sh[4], sc[4];
        if (a.xin_f32) {
#pragma unroll
            for (int u = 0; u < 2; ++u)
#pragma unroll
                for (int j = 0; j < 4; ++j) v[u][j] = *(const f32x4*)((const float*)xrb + xoff + u * DM + 8 * lane + 512 * (j >> 1) + 4 * (j & 1));
        } else {
#pragma unroll
            for (int u = 0; u < 2; ++u)
#pragma unroll
                for (int jb = 0; jb < 2; ++jb) { const u32x4 xw = *(const u32x4*)((const bf16_t*)xrb + xoff + u * DM + 8 * lane + 512 * jb); v[u][2 * jb] = bfx4_lo(xw); v[u][2 * jb + 1] = bfx4_hi(xw); }
        }
        if (a.has_y) {
            if (isl || !a.ctx_split) {
#pragma unroll
                for (int u = 0; u < 2; ++u)
#pragma unroll
                    for (int jb = 0; jb < 2; ++jb) { const u32x4 yw = *(const u32x4*)(xn + u * DM + 8 * lane + 512 * jb); y[u][2 * jb] = bfx4_lo(yw); y[u][2 * jb + 1] = bfx4_hi(yw); }
            } else {
                const float* part = (const float*)p.out;
#pragma unroll
                for (int u = 0; u < 2; ++u)
#pragma unroll
                    for (int j = 0; j < 4; ++j) { const float* pp = part + (size_t)(m0 + u - ML) * DM + 8 * lane + 512 * (j >> 1) + 4 * (j & 1); f32x4 s = *(const f32x4*)pp;
#pragma unroll
                        for (int k = 1; k < pg8::KSPLIT; ++k) s += *(const f32x4*)(pp + (size_t)k * MC * DM);
                        y[u][j] = s; }
            }
#pragma unroll
            for (int j = 0; j < 4; ++j) gt[j] = *(const f32x4*)(a.mod_cur + moff + a.gate_off + 8 * lane + 512 * (j >> 1) + 4 * (j & 1));
        }
        if (a.write_xn) {
#pragma unroll
            for (int j = 0; j < 4; ++j) { const int c = 8 * lane + 512 * (j >> 1) + 4 * (j & 1); sh[j] = *(const f32x4*)(a.mod_nxt + moff + a.sh_off + c); sc[j] = *(const f32x4*)(a.mod_nxt + moff + a.sc_off + c); }
        }
        __builtin_amdgcn_sched_barrier(0);
        if (a.has_y) {
#pragma unroll
            for (int u = 0; u < 2; ++u) {
                float s = 0.f;
#pragma unroll
                for (int j = 0; j < 4; ++j) s += (y[u][j][0] * y[u][j][0] + y[u][j][1] * y[u][j][1]) + (y[u][j][2] * y[u][j][2] + y[u][j][3] * y[u][j][3]);
                const float rstd = rsqrtf(wave_sum(s) * (1.f / DM) + EPS);
#pragma unroll
                for (int j = 0; j < 4; ++j) v[u][j] = v[u][j] + gt[j] * (y[u][j] * rstd * gpo[j]);
                if (a.xout_f32) {
#pragma unroll
                    for (int j = 0; j < 4; ++j) *(f32x4*)((float*)xob + xoff + u * DM + 8 * lane + 512 * (j >> 1) + 4 * (j & 1)) = v[u][j];
                } else {
#pragma unroll
                    for (int jb = 0; jb < 2; ++jb) { u32x4 w; w.x = cvt_pk_bf16(v[u][2 * jb][0], v[u][2 * jb][1]); w.y = cvt_pk_bf16(v[u][2 * jb][2], v[u][2 * jb][3]);
                        w.z = cvt_pk_bf16(v[u][2 * jb + 1][0], v[u][2 * jb + 1][1]); w.w = cvt_pk_bf16(v[u][2 * jb + 1][2], v[u][2 * jb + 1][3]);
                        *(u32x4*)((bf16_t*)xob + xoff + u * DM + 8 * lane + 512 * jb) = w; v[u][2 * jb] = bfx4_lo(w); v[u][2 * jb + 1] = bfx4_hi(w); }
                } }
        }
        if (a.write_xn) {
#pragma unroll
            for (int u = 0; u < 2; ++u) {
                float s2 = 0.f;
#pragma unroll
                for (int j = 0; j < 4; ++j) s2 += (v[u][j][0] * v[u][j][0] + v[u][j][1] * v[u][j][1]) + (v[u][j][2] * v[u][j][2] + v[u][j][3] * v[u][j][3]);
                const float rstd = rsqrtf(wave_sum(s2) * (1.f / DM) + EPS);
#pragma unroll
                for (int jb = 0; jb < 2; ++jb) { const f32x4 h0 = (v[u][2 * jb] * rstd * gpr[2 * jb]) * (sc[2 * jb] + 1.f) + sh[2 * jb], h1 = (v[u][2 * jb + 1] * rstd * gpr[2 * jb + 1]) * (sc[2 * jb + 1] + 1.f) + sh[2 * jb + 1];
                    u32x4 w; w.x = cvt_pk_bf16(h0[0], h0[1]); w.y = cvt_pk_bf16(h0[2], h0[3]); w.z = cvt_pk_bf16(h1[0], h1[1]); w.w = cvt_pk_bf16(h1[2], h1[3]);
                    *(u32x4*)(xn + u * DM + 8 * lane + 512 * jb) = w; } }
        }
    }
}

constexpr float LOG2E = 1.4426950408889634f;
constexpr int RPB_PITCH = 64, RPB_OFF = 16;

constexpr int AT_KC = 0, AT_VC = 32768;
constexpr int AT_KL = 0, AT_VL = 73728, AT_VLP = 1280, AT_RPB = AT_VL + 64 * AT_VLP;
static_assert(AT_RPB + 15 * 64 * 4 <= LDS_BYTES - 16, "attention LDS map");
__device__ __forceinline__ int kswz(int key) { return ((key >> 1) & 1) | (((key >> 3) & 3) << 1); }

template <bool LOC>
__device__ __forceinline__ void attn_half(const LAS unsigned char* lds, int kaddr0, int kaddr1, int kcs, int vrow, int vchunk0, int vcs, int vpitch_dt,
                                          const LAS float* bp, int elo, const bf16x8 q0, const bf16x8 q1, float& mx, float& lsum, f32x4 (&o)[4], int g, int qi) {
    constexpr float SC = 0.125f * LOG2E;
    float s[8][8];
    bf16x8 kf[2][4];
#define AH_LDK(c, bufi) do { kf[bufi][0] = *(const LAS bf16x8*)(lds + kaddr0 + (c) * kcs); kf[bufi][1] = *(const LAS bf16x8*)(lds + kaddr1 + (c) * kcs); \
        kf[bufi][2] = *(const LAS bf16x8*)(lds + kaddr0 + (c) * kcs + 512); kf[bufi][3] = *(const LAS bf16x8*)(lds + kaddr1 + (c) * kcs + 512); } while (0)
    AH_LDK(0, 0);
#pragma unroll
    for (int c = 0; c < 8; ++c) {
        if (c < 7) AH_LDK(c + 1, (c + 1) & 1);
        __builtin_amdgcn_sched_barrier(0);
        f32x4 t0 = (f32x4){0.f, 0.f, 0.f, 0.f}, t1 = (f32x4){0.f, 0.f, 0.f, 0.f};
        t0 = __builtin_amdgcn_mfma_f32_16x16x32_bf16(kf[c & 1][0], q0, t0, 0, 0, 0); t1 = __builtin_amdgcn_mfma_f32_16x16x32_bf16(kf[c & 1][2], q0, t1, 0, 0, 0);
        t0 = __builtin_amdgcn_mfma_f32_16x16x32_bf16(kf[c & 1][1], q1, t0, 0, 0, 0); t1 = __builtin_amdgcn_mfma_f32_16x16x32_bf16(kf[c & 1][3], q1, t1, 0, 0, 0);
#pragma unroll
        for (int e = 0; e < 8; ++e) { const float a = (e < 4) ? t0[e] : t1[e - 4];
            if (LOC) { const float bv = bp[c * RPB_PITCH + e]; const bool ok = (e >= elo) && (e < elo + 16); s[c][e] = ok ? (a * SC + bv) : -INFINITY; }
            else s[c][e] = a * SC; }
        __builtin_amdgcn_sched_barrier(0);
    }
#undef AH_LDK
    float m2 = mx;
#pragma unroll
    for (int c = 0; c < 8; ++c)
#pragma unroll
        for (int e = 0; e < 8; ++e) m2 = fmaxf(m2, s[c][e]);
    m2 = fmaxf(m2, __shfl_xor(m2, 16)); m2 = fmaxf(m2, __shfl_xor(m2, 32));
    const float alpha = __builtin_amdgcn_exp2f(mx - m2);
    mx = m2; lsum *= alpha;
#pragma unroll
    for (int dt = 0; dt < 4; ++dt) o[dt] = o[dt] * alpha;
    bf16x8 vf[2][4];
#define AH_LDV(c, bufi) do { const int vaddr = vrow + (((vchunk0 + (c) * vcs + g) ^ qi) << 4); _Pragma("unroll") for (int dt = 0; dt < 4; ++dt) vf[bufi][dt] = *(const LAS bf16x8*)(lds + vaddr + dt * vpitch_dt); } while (0)
    AH_LDV(0, 0);
#pragma unroll
    for (int c = 0; c < 8; ++c) {
        if (c < 7) AH_LDV(c + 1, (c + 1) & 1);
        __builtin_amdgcn_sched_barrier(0);
        float pe[8];
#pragma unroll
        for (int e = 0; e < 8; ++e) { pe[e] = __builtin_amdgcn_exp2f(s[c][e] - mx); lsum += pe[e]; }
        u32x4 pw; pw.x = cvt_pk_bf16(pe[0], pe[1]); pw.y = cvt_pk_bf16(pe[2], pe[3]); pw.z = cvt_pk_bf16(pe[4], pe[5]); pw.w = cvt_pk_bf16(pe[6], pe[7]);
        const bf16x8 pb = __builtin_bit_cast(bf16x8, pw);
#pragma unroll
        for (int dt = 0; dt < 4; ++dt) o[dt] = __builtin_amdgcn_mfma_f32_16x16x32_bf16(vf[c & 1][dt], pb, o[dt], 0, 0, 0);
        __builtin_amdgcn_sched_barrier(0);
    }
#undef AH_LDV
}

__device__ __forceinline__ void attn_store(bf16_t* MIX, int qtok, int h, int g, float lsum, const f32x4 (&o)[4]) {
    lsum += __shfl_xor(lsum, 16); lsum += __shfl_xor(lsum, 32);
    const float inv = 1.f / lsum;
    bf16_t* op = MIX + (size_t)qtok * DM + 512 + h * 64 + 4 * g;
#pragma unroll
    for (int dt = 0; dt < 4; ++dt) { u32x2 w; w.x = cvt_pk_bf16(o[dt][0] * inv, o[dt][1] * inv); w.y = cvt_pk_bf16(o[dt][2] * inv, o[dt][3] * inv); *(u32x2*)(op + 16 * dt) = w; }
}

__device__ __forceinline__ void phase_mixer(const Params& p, LAS unsigned char* lds, int l, bool with_ctx, int G, int tid, int wave, int lane, int rep_attn, int rep_pool) {
    const bf16_t* PB = (const bf16_t*)(p.ws + WS_PB); const bf16_t* VT = (const bf16_t*)(p.ws + WS_VT); bf16_t* MIX = (bf16_t*)(p.ws + WS_MIX);
    const int gw = blockIdx.x * NWAVES + wave, NGW = G * NWAVES;
    const int qi = lane & 15, g = lane >> 4, kap = 8 * (qi >> 2) + (qi & 3);
#pragma unroll 1
    for (int ra = 0; ra < rep_attn; ++ra)
#pragma unroll 1
    for (int I = blockIdx.x; I < 64 * 32; I += G) {
        const int x = I & 7, t = I >> 3, j = t & 31, rho = t >> 5, pr = rho * 8 + x, b = pr >> 3, h = pr & 7;
        const int r0 = 2 * j, rs0 = min(max(r0 - 4, 0), 56);
        const int r = r0 + (wave >> 2), n = wave & 3, rs = min(max(r - 4, 0), 56), kc0 = min(max(16 * n - 8, 0), 32);
        const int qc = 16 * n + qi, qs = min(max(qc - 8, 0), 48);
        const int sel = (j - 2 * rho) & 31;
        const int npass = (with_ctx && sel < 2) ? 2 : 1;
        {
            u32x4 kreg[4], vreg[4];
            const bf16_t* ksrc = PB + (size_t)(ML + b * CT + (tid >> 3)) * PBW + 1024 + h * 64 + (tid & 7) * 8;
            const bf16_t* vsrc = VT + (size_t)(h * 64 + (tid >> 5)) * VTP + ML + b * CT + (tid & 31) * 8;
#pragma unroll
            for (int ps = 0; ps < 4; ++ps) { kreg[ps] = *(const u32x4*)(ksrc + (size_t)(ps * 64) * PBW); vreg[ps] = *(const u32x4*)(vsrc + (size_t)(ps * 16) * VTP); }
            __builtin_amdgcn_sched_barrier(0);
#pragma unroll
            for (int ps = 0; ps < 4; ++ps) { const int key = ps * 64 + (tid >> 3), d = ps * 16 + (tid >> 5);
                *(LAS u32x4*)(lds + AT_KC + key * 128 + ((((tid & 7) ^ kswz(key))) << 4)) = kreg[ps];
                *(LAS u32x4*)(lds + AT_VC + d * 512 + ((((tid & 31) ^ (d & 15))) << 4)) = vreg[ps]; }
        }
        __syncthreads();
        float mxA = -INFINITY, lA = 0.f; f32x4 oA[4]; bf16x8 qA0, qA1;
        {
            const int kl = kap, ka0 = AT_KC + kl * 128 + ((g ^ kswz(kl)) << 4), ka1 = AT_KC + kl * 128 + (((g + 4) ^ kswz(kl)) << 4);
            const int vrow = AT_VC + qi * 512;
#pragma unroll 1
            for (int ps = 0; ps < npass; ++ps) {
                const int qtok = (ps == 0) ? (b * SEQ + r * 64 + 16 * n + qi) : (ML + b * CT + 16 * (sel * 8 + wave) + qi);
                const bf16_t* qp = PB + (size_t)qtok * PBW + 512 + h * 64 + 8 * g;
                const bf16x8 q0 = *(const bf16x8*)qp, q1 = *(const bf16x8*)(qp + 32);
                float mx = -INFINITY, ls = 0.f; f32x4 o[4];
#pragma unroll
                for (int dt = 0; dt < 4; ++dt) o[dt] = (f32x4){0.f, 0.f, 0.f, 0.f};
                attn_half<false>(lds, ka0, ka1, 32 * 128, vrow, 0, 4, 16 * 512, nullptr, 0, q0, q1, mx, ls, o, g, qi);
                if (ps == 0) { mxA = mx; lA = ls; qA0 = q0; qA1 = q1;
#pragma unroll
                    for (int dt = 0; dt < 4; ++dt) oA[dt] = o[dt]; }
                else attn_store(MIX, qtok, h, g, ls, o);
            }
        }
        __syncthreads();
        {
            const int tok0 = b * SEQ + rs0 * 64;
            const bf16_t* ksrc = PB + (size_t)(tok0 + (tid >> 3)) * PBW + 1024 + h * 64 + (tid & 7) * 8;
            u32x4 kreg[9], vreg[9];
#pragma unroll
            for (int ps = 0; ps < 9; ++ps) { const int idx = ps * 512 + tid, d = idx / 72, ch = idx - d * 72;
                kreg[ps] = *(const u32x4*)(ksrc + (size_t)(ps * 64) * PBW);
                vreg[ps] = *(const u32x4*)(VT + (size_t)(h * 64 + d) * VTP + tok0 + ch * 8); }
            __builtin_amdgcn_sched_barrier(0);
#pragma unroll
            for (int ps = 0; ps < 9; ++ps) { const int key = ps * 64 + (tid >> 3), idx = ps * 512 + tid, d = idx / 72, ch = idx - d * 72;
                *(LAS u32x4*)(lds + AT_KL + key * 128 + ((((tid & 7) ^ kswz(key))) << 4)) = kreg[ps];
                *(LAS u32x4*)(lds + AT_VL + d * AT_VLP + ((ch ^ (d & 15)) << 4)) = vreg[ps]; }
            LAS float* rp = (LAS float*)(lds + AT_RPB);
            for (int i = tid; i < 15 * RPB_PITCH; i += NTHR) { const int row = i >> 6, cc = (i & 63) - RPB_OFF; rp[i] = (cc >= 0 && cc < 31) ? p.in[I_RPB][(size_t)(l * 8 + h) * 15 * 31 + row * 31 + cc] * LOG2E : 0.f; }
        }
        __syncthreads();
        {
            const int kl = (rs - rs0) * 64 + kc0 + kap, ka0 = AT_KL + kl * 128 + ((g ^ kswz(kl)) << 4), ka1 = AT_KL + kl * 128 + (((g + 4) ^ kswz(kl)) << 4);
            const int vrow = AT_VL + qi * AT_VLP, vch0 = (rs - rs0) * 8 + (kc0 >> 3);
            const LAS float* bp = (const LAS float*)(lds + AT_RPB) + (rs - r + 7) * RPB_PITCH + RPB_OFF + (kc0 + 8 * g - qc + 15);
            attn_half<true>(lds, ka0, ka1, 64 * 128, vrow, vch0, 8, 16 * AT_VLP, bp, qs - kc0 - 8 * g, qA0, qA1, mxA, lA, oA, g, qi);
            attn_store(MIX, b * SEQ + r * 64 + 16 * n + qi, h, g, lA, oA);
        }
        __syncthreads();
    }
    const int nrun = (with_ctx ? MT : ML) / 16;
    const int grp = lane >> 4, lo = 1 << grp, hi = lo - 1;
#pragma unroll 1
    for (int rp = 0; rp < rep_pool; ++rp)
#pragma unroll 1
    for (int run = gw; run < nrun; run += NGW) {
        const int tok0 = run * 16; const bool isl = tok0 < ML;
        const int base = isl ? (tok0 & ~(SEQ - 1)) : (ML + ((tok0 - ML) & ~(CT - 1))), len = isl ? SEQ : CT, t0 = tok0 - base;
        u32x4 w[31];
#pragma unroll
        for (int i = 0; i < 31; ++i) { const int tt = min(max(t0 - 8 + i, 0), len - 1); w[i] = *(const u32x4*)(PB + (size_t)(base + tt) * PBW + 8 * lane); }
#pragma unroll
        for (int o = 0; o < 16; ++o) {
            const int t = t0 + o, st = max(t - lo, 0), en = min(t + hi + 1, len);
            float acc[8];
#pragma unroll
            for (int e = 0; e < 8; ++e) acc[e] = 0.f;
#pragma unroll
            for (int i = 0; i < 16; ++i) { const int tt = t + i - 8; const float wt = (tt >= st && tt < en) ? 1.f : 0.f; const u32x4 ww = w[o + i];
                acc[0] += wt * bf_lo(ww.x); acc[1] += wt * bf_hi(ww.x); acc[2] += wt * bf_lo(ww.y); acc[3] += wt * bf_hi(ww.y);
                acc[4] += wt * bf_lo(ww.z); acc[5] += wt * bf_hi(ww.z); acc[6] += wt * bf_lo(ww.w); acc[7] += wt * bf_hi(ww.w); }
            const float ic = 1.f / (float)(en - st);
            const u32x4 sw = w[o + 8];
            u32x4 ov; ov.x = cvt_pk_bf16(acc[0] * ic - bf_lo(sw.x), acc[1] * ic - bf_hi(sw.x)); ov.y = cvt_pk_bf16(acc[2] * ic - bf_lo(sw.y), acc[3] * ic - bf_hi(sw.y));
            ov.z = cvt_pk_bf16(acc[4] * ic - bf_lo(sw.z), acc[5] * ic - bf_hi(sw.z)); ov.w = cvt_pk_bf16(acc[6] * ic - bf_lo(sw.w), acc[7] * ic - bf_hi(sw.w));
            *(u32x4*)(MIX + (size_t)(tok0 + o) * DM + 8 * lane) = ov;
        }
    }
    __syncthreads();
}

constexpr int NPHASE = 2 + 7 * DEPTH;
__global__ void __launch_bounds__(NTHR) fwd_kernel(Params p) {
    extern __shared__ __attribute__((aligned(16))) unsigned char lds_raw[];
    LAS unsigned char* lds = (LAS unsigned char*)lds_raw;
    const int G = gridDim.x;
    const int ph_hi = p.ph_hi;
    volatile LAS unsigned* xst = (volatile LAS unsigned*)(lds + LDS_BYTES - 16);
    if (threadIdx.x < 4) xst[threadIdx.x] = 0u;
    unsigned* const xbar = (unsigned*)(p.ws + WS_BAR);
    if (blockIdx.x == 0) for (int i = threadIdx.x; i < XCD_BAR_WORDS; i += NTHR) __hip_atomic_store(&xbar[i], 0u, __ATOMIC_RELAXED, __HIP_MEMORY_SCOPE_AGENT);
    __syncthreads();
    XcdBarrier xb; xb.bar = xbar; xb.x = 0; xb.st = xst;
    bool xb_posted = false;
    for (int ph = p.ph_lo; ph < ph_hi; ++ph) {
#if PROBE_DUP
        int ptype = -1; if (ph == 0) ptype = 0; else if (ph >= 2) { const int s_ = (ph - 2) % 7; ptype = (s_ == 0) ? 2 : (s_ == 1) ? 1 : (s_ == 2) ? 3 : (s_ == 4) ? 4 : (s_ == 5) ? 5 : -1; }
        const int nrep = (ptype >= 0 && ((PROBE_DUP >> ptype) & 1)) ? 2 : 1;
        for (int rep = 0; rep < nrep; ++rep) {
        if (rep) __syncthreads();
#endif
        int z = 0; asm volatile("s_mov_b32 %0, 0" : "=s"(z));
        Params q;
#pragma unroll
        for (int i = 0; i < 17; ++i) q.in[i] = p.in[i] + z;
        q.out = p.out + z; q.ws = p.ws + z; q.ph_lo = 0; q.ph_hi = 0;
        const int tid = threadIdx.x + z, lane = tid & 63, wave = __builtin_amdgcn_readfirstlane(tid >> 6);
        const float* mod = (const float*)(q.ws + WS_MOD);
        bf16_t* XN = (bf16_t*)(q.ws + WS_XN);
        bf16_t* ctxr = (bf16_t*)(q.ws + WS_CTXR); bf16_t* xres = (bf16_t*)(q.ws + WS_XR);
        if (ph == 0) phase_prologue(q, lds, G, tid, wave, lane);
        else if (ph == 1) {
            RowArgs a{}; a.xlat = q.in[I_X]; a.xctx = q.in[I_CTX]; a.xin_f32 = true; a.nrows = MT; a.has_y = false; a.write_xn = true;
            a.gpre = q.in[I_GPREMIX]; a.mod_nxt = mod; a.sh_off = 0; a.sc_off = DM;
            phase_rows(q, a, G, wave, lane);
        } else {
            const int l = (ph - 2) / 7, s = (ph - 2) % 7; const bool last = (l == DEPTH - 1);
            const int nMrows = last ? ML / 256 : MT / 256;
            if (s == 0) {
                pg8::Gemm g{XN, (const bf16_t*)(q.ws + WS_WIN) + (size_t)l * NIN * DM, DM, 6};
                pg8::StaticOrder S; S.init(MT / 256, 8, G, (int)blockIdx.x);
                pg8::Epi<0> E{(bf16_t*)(q.ws + WS_PB), (bf16_t*)(q.ws + WS_VT), nullptr};
                pg8::gemm_phase<pg8::Epi<0>, true>(lds, g, S, E, tid);
            } else if (s == 1) {
                phase_mixer(q, lds, l, !last, G, tid, wave, lane, 1 + ((PROBE_DUP >> 8) & 1), 1 + ((PROBE_DUP >> 6) & 1));
            } else if (s == 2) {
                pg8::Gemm g{(const bf16_t*)(q.ws + WS_MIX), (const bf16_t*)(q.ws + WS_WOUT) + (size_t)l * DM * DM, DM, 1 << 30};
                pg8::StaticOrder S; S.init(ML / 256, 4, G, (int)blockIdx.x, last ? 0 : MC / 256);
                pg8::Epi<1> E{XN, nullptr, q.out};
                pg8::gemm_phase<pg8::Epi<1>, true>(lds, g, S, E, tid);
            } else if (s == 3) {
                RowArgs a{}; a.xlat = (l == 0) ? (const void*)q.in[I_X] : (const void*)xres; a.xctx = (l == 0) ? (const void*)q.in[I_CTX] : (const void*)ctxr; a.xin_f32 = (l == 0); a.olat = xres; a.octx = ctxr; a.xout_f32 = false;
                a.gpost = q.in[I_GPOSTMIX] + l * DM; a.mod_cur = mod + (size_t)l * 9 * NMOD; a.gate_off = 2 * DM;
                a.gpre = q.in[I_GPREMLP] + l * DM; a.mod_nxt = a.mod_cur; a.sh_off = 3 * DM; a.sc_off = 4 * DM;
                a.nrows = nMrows * 256; a.has_y = true; a.write_xn = true; a.ctx_split = true;
                phase_rows(q, a, G, wave, lane);
            } else if (s == 4) {
                pg8::Gemm g{XN, (const bf16_t*)(q.ws + WS_W1) + (size_t)l * FF * DM, DM, 1 << 30};
                pg8::StaticOrder S; S.init(nMrows, 16, G, (int)blockIdx.x);
                pg8::Epi<2> E{(bf16_t*)(q.ws + WS_H), nullptr, nullptr};
                pg8::gemm_phase<pg8::Epi<2>, true>(lds, g, S, E, tid);
            } else if (s == 5) {
                pg8::Gemm g{(const bf16_t*)(q.ws + WS_H), (const bf16_t*)(q.ws + WS_W2) + (size_t)l * DM * FF, FF, 1 << 30};
                pg8::StaticOrder S; S.init(ML / 256, 4, G, (int)blockIdx.x, last ? 0 : MC / 256);
                pg8::Epi<1> E{XN, nullptr, q.out};
                pg8::gemm_phase<pg8::Epi<1>, true>(lds, g, S, E, tid);
            } else {
                RowArgs a{}; a.xlat = xres; a.xctx = ctxr; a.xin_f32 = false; a.olat = last ? (void*)q.out : (void*)xres; a.octx = ctxr; a.xout_f32 = last;
                a.gpost = q.in[I_GPOSTMLP] + l * DM; a.mod_cur = mod + (size_t)l * 9 * NMOD; a.gate_off = 5 * DM;
                a.nrows = nMrows * 256; a.has_y = true; a.write_xn = !last; a.ctx_split = true;
                if (!last) { a.gpre = q.in[I_GPREMIX] + (l + 1) * DM; a.mod_nxt = mod + (size_t)(l + 1) * 9 * NMOD; a.sh_off = 0; a.sc_off = DM; }
                phase_rows(q, a, G, wave, lane);
            }
        }
#if PROBE_DUP
        }
#endif
        if (ph + 1 < ph_hi) {
            if (!xb_posted) { cg::this_grid().sync(); xb = xcd_barrier_post(xbar, xst); xb_posted = true; }
            else { xcd_barrier(xb); if (PROBE_DUP & 128) xcd_barrier(xb); }
        }
    }
}

extern "C" void kernel_launch(void* const* d_in, const int* in_sizes, int n_in, void* d_out, int out_size, void* d_ws, size_t ws_size, hipStream_t stream) {
    static int grid = 0;
    if (grid == 0) {
        if (n_in != 17 || in_sizes[0] != ML * DM || out_size != ML * DM || ws_size < WS_END) { fprintf(stderr, "kernel_launch: unexpected shapes (n_in %d, in0 %d, out %d, ws %zu)\n", n_in, n_in > 0 ? in_sizes[0] : -1, out_size, ws_size); grid = -1; return; }
        int dev = 0, cus = 0, per_cu = 0;
        (void)hipGetDevice(&dev);
        (void)hipDeviceGetAttribute(&cus, hipDeviceAttributeMultiprocessorCount, dev);
        if (hipFuncSetAttribute((const void*)fwd_kernel, hipFuncAttributeMaxDynamicSharedMemorySize, LDS_BYTES) != hipSuccess) { fprintf(stderr, "kernel_launch: hipFuncSetAttribute failed\n"); grid = -1; return; }
        if (hipOccupancyMaxActiveBlocksPerMultiprocessor(&per_cu, (const void*)fwd_kernel, NTHR, LDS_BYTES) != hipSuccess || per_cu < 1) { fprintf(stderr, "kernel_launch: occupancy query says %d\n", per_cu); per_cu = 1; }
        (void)hipGetLastError();
        grid = cus * 1;
    }
    if (grid < 0) return;
    Params p{};
    for (int i = 0; i < 17; ++i) p.in[i] = (const float*)d_in[i];
    p.out = (float*)d_out; p.ws = (unsigned char*)d_ws;
#if MK_SPLIT
    for (int ph = 0; ph < NPHASE; ++ph) { p.ph_lo = ph; p.ph_hi = ph + 1; hipLaunchKernelGGL(fwd_kernel, dim3(grid), dim3(NTHR), LDS_BYTES, stream, p); }
#else
    p.ph_lo = 0; p.ph_hi = NPHASE;
    void* args[] = {&p};
    hipError_t e = hipLaunchCooperativeKernel((const void*)fwd_kernel, dim3(grid), dim3(NTHR), args, LDS_BYTES, stream);
    if (e != hipSuccess) fprintf(stderr, "cooperative launch failed: %s (grid %d)\n", hipGetErrorString(e), grid);
#endif
}
```

```cpp
#include <hip/hip_runtime.h>
#include <hip/hip_cooperative_groups.h>
#include <cstdio>
#include <cstdint>
namespace cg = cooperative_groups;

#ifndef MK_SPLIT
#define MK_SPLIT 0
#endif

#ifndef PROBE_DUP
#define PROBE_DUP 0
#endif
#define LAS __attribute__((address_space(3)))
typedef unsigned short bf16_t;
typedef short bf16x8 __attribute__((ext_vector_type(8)));
typedef float f32x4 __attribute__((ext_vector_type(4)));
typedef float f32x2 __attribute__((ext_vector_type(2)));
typedef unsigned u32x4 __attribute__((ext_vector_type(4)));
typedef unsigned u32x2 __attribute__((ext_vector_type(2)));

constexpr int DM = 1024, NB = 8, SEQ = 4096, CT = 256, DEPTH = 4, FF = 4096, NIN = 2048;
constexpr int ML = NB * SEQ, MC = NB * CT, MT = ML + MC;
constexpr int NMOD = 6 * DM;
constexpr int VTP = MT + 128;
constexpr int PBW = 1536;
constexpr float EPS = 1e-6f;
constexpr int NWAVES = 8, NTHR = 512;

constexpr size_t MiB = 1u << 20;
constexpr size_t WS_MOD = 0;
constexpr size_t WS_SS = 1 * MiB;
constexpr size_t WS_BAR = 3 * MiB + 512 * 1024;
constexpr size_t WS_CTXR = 4 * MiB;
constexpr size_t WS_WIN = 12 * MiB;
constexpr size_t WS_WOUT = 28 * MiB;
constexpr size_t WS_W1 = 36 * MiB;
constexpr size_t WS_W2 = 68 * MiB;
constexpr size_t WS_XN = 100 * MiB;
constexpr size_t WS_H = 168 * MiB;
constexpr size_t WS_PB = WS_H;
constexpr size_t WS_VT = 270 * MiB;
constexpr size_t WS_MIX = 306 * MiB;
constexpr size_t WS_XR = 440 * MiB;
constexpr size_t WS_END = 504 * MiB;
static_assert(WS_PB + (size_t)MT * PBW * 2 <= WS_VT && WS_VT + (size_t)512 * VTP * 2 <= WS_MIX && WS_MIX + (size_t)MT * DM * 2 <= WS_END, "ws");
static_assert(WS_H + (size_t)MT * FF * 2 <= WS_XR && WS_XR + (size_t)ML * DM * 2 <= WS_END && (size_t)8 * MC * DM * 4 <= (size_t)ML * DM * 4, "ws h");

constexpr int LDS_BYTES = 163840;

typedef __bf16 bf16v2 __attribute__((ext_vector_type(2)));
__device__ __forceinline__ unsigned cvt_pk_bf16(float lo, float hi) { const f32x2 v = (f32x2){lo, hi}; return __builtin_bit_cast(unsigned, __builtin_convertvector(v, bf16v2)); }
__device__ __forceinline__ float bf_lo(unsigned w) { return __uint_as_float(w << 16); }
__device__ __forceinline__ float bf_hi(unsigned w) { return __uint_as_float(w & 0xffff0000u); }
template <int CTRL> __device__ __forceinline__ float dpp_f(float v) { return __builtin_bit_cast(float, __builtin_amdgcn_update_dpp(0, __builtin_bit_cast(int, v), CTRL, 0xf, 0xf, false)); }
__device__ __forceinline__ float wave_sum(float v) {
    v += dpp_f<0xB1>(v); v += dpp_f<0x4E>(v); v += dpp_f<0x141>(v); v += dpp_f<0x140>(v);
    v += __shfl_xor(v, 16); v += __shfl_xor(v, 32);
    return v;
}
#define LDS_WAIT() asm volatile("s_waitcnt lgkmcnt(0)" ::: "memory")

namespace pg8 {
constexpr int BM = 256, BK = 64, HALF = 128, HTB = HALF * BK * 2, STAGE_BYTES = 8 * HTB, NXCD = 8, WGM = 8;
__host__ __device__ __forceinline__ int lds_byte(int r, int c) { const int st = (r >> 4) * 2 + (c >> 5), rr = r & 15, cc = c & 31, ob = rr * 64 + cc * 2; return st * 1024 + (ob ^ (((ob >> 9) & 1) << 5)); }
__host__ __device__ __forceinline__ void stage_rc(int b, int& R, int& C) { const int st = b / 1024, sb = b % 1024, swz = sb ^ (((sb >> 9) & 1) << 5); R = (st >> 1) * 16 + swz / 64; C = (st & 1) * 32 + (swz % 64) / 2; }
__host__ __device__ __forceinline__ int perm32(int rho) { const int n = rho >> 4, i = rho & 15; return 8 * (i >> 2) + 4 * n + (i & 3); }

struct Unit { int pm, pn, ks; };
constexpr int KSPLIT = 8;
struct Gemm { const bf16_t* A; const bf16_t* Bt; int K; int nN_main; };

struct StaticOrder {
    int nM, nN, nwg, G, c, nsplit;
    __device__ __forceinline__ void init(int nM_, int nN_, int G_, int c_, int nsplit_ = 0) { nM = nM_; nN = nN_; nwg = nM * nN; G = G_; c = c_; nsplit = nsplit_; }
    __device__ __forceinline__ bool next(int i, Unit& u) const {
        const long L = (long)i * G + c; if (L >= nwg + nsplit * nN * KSPLIT) return false;
        int pm, pn, ks;
        if (L >= nwg) { const int e = (int)L - nwg, cu = e / KSPLIT; ks = e % KSPLIT; pm = nM + cu / nN; pn = cu % nN; }
        else {
            int wgid = (int)L; { const int q = nwg / NXCD, r = nwg % NXCD, xcd = wgid % NXCD, off = wgid / NXCD; wgid = (xcd < r ? xcd * (q + 1) : r * (q + 1) + (xcd - r) * q) + off; }
            const int nig = WGM * nN, gid = wgid / nig, fm = gid * WGM, gsz = (nM - fm) < WGM ? (nM - fm) : WGM;
            pm = fm + ((wgid % nig) % gsz); pn = (wgid % nig) / gsz; ks = -1;
        }
        u.pm = pm; u.pn = pn; u.ks = ks; return true;
    }
};

template <int MODE> struct Epi {
    bf16_t* O; bf16_t* O2; float* part;
    __device__ __forceinline__ void operator()(const f32x4 (&acc)[2][2][4][2], const Unit& u, int wr, int wc, int fr, int fq) const {
        int prow = u.pm, pcol = u.pn; bf16_t* base = O; size_t ldc = (MODE == 0) ? PBW : (MODE == 1 ? DM : FF);
        if (MODE == 0 && u.pn >= 6) { prow = u.pn - 6; pcol = u.pm; base = O2; ldc = VTP; }
        const int row0 = prow * BM + wr * 64 + fr, col0 = pcol * BM + wc * 32 + 8 * fq;
        if (MODE == 1 && u.ks >= 0) {
            float* pb = part + ((size_t)u.ks * MC + (size_t)(row0 - ML)) * DM + col0;
#pragma unroll
            for (int ai = 0; ai < 2; ++ai)
#pragma unroll
                for (int m = 0; m < 4; ++m) { float* rowp = pb + (size_t)(ai * HALF + m * 16) * DM;
#pragma unroll
                    for (int bj = 0; bj < 2; ++bj) { *(f32x4*)(rowp + bj * HALF) = acc[ai][bj][m][0]; *(f32x4*)(rowp + bj * HALF + 4) = acc[ai][bj][m][1]; } }
            return;
        }
#pragma unroll
        for (int ai = 0; ai < 2; ++ai)
#pragma unroll
            for (int m = 0; m < 4; ++m) { bf16_t* rowp = base + (size_t)(row0 + ai * HALF + m * 16) * ldc + col0;
#pragma unroll
                for (int bj = 0; bj < 2; ++bj) { f32x4 v0 = acc[ai][bj][m][0], v1 = acc[ai][bj][m][1];
                    if (MODE == 2) {
#pragma unroll
                        for (int e = 0; e < 4; ++e) { const float a = fmaxf(v0[e], 0.f), b = fmaxf(v1[e], 0.f); v0[e] = a * a; v1[e] = b * b; } }
                    u32x4 w; w.x = cvt_pk_bf16(v0[0], v0[1]); w.y = cvt_pk_bf16(v0[2], v0[3]); w.z = cvt_pk_bf16(v1[0], v1[1]); w.w = cvt_pk_bf16(v1[2], v1[3]);
                    *(u32x4*)(rowp + bj * HALF) = w; } }
    }
};

template <class EpiT, bool ALIGN_EPI>
__device__ __forceinline__ void gemm_phase(LAS unsigned char* lds, const Gemm g, const StaticOrder& S, const EpiT& E, const int tid) {
    const int wid = __builtin_amdgcn_readfirstlane(tid >> 6), lane = tid & 63, wr = wid >> 2, wc = wid & 3, fr = lane & 15, fq = lane >> 4;
    const int K = g.K;
    unsigned voffA[2], voffB[2];
#pragma unroll
    for (int i = 0; i < 2; ++i) { int R, C; stage_rc(tid * 16 + i * 8192, R, C); const int Rb = (R & ~31) + perm32(R & 31);
        voffA[i] = (unsigned)(R * K + C) * 2u; voffB[i] = (unsigned)(Rb * K + C) * 2u; }
    const size_t kstep = (size_t)(BK * 2);
    const size_t hstep = (size_t)HALF * K * 2;
    const size_t tstep = 2 * hstep;
    const unsigned ldsw = (unsigned)wid * 1024u;
    const int aoff = lds_byte(wr * 64 + fr, fq * 8), boff = lds_byte(wc * 32 + fr, fq * 8);
#define PG8_SA(b, h) (((b) * 2 + (h)) * HTB)
#define PG8_SB(b, h) ((4 + (b) * 2 + (h)) * HTB)
#define PG8_STAGE(bufoff, gbase, voff) do { _Pragma("unroll") for (int _i = 0; _i < 2; ++_i) \
        __builtin_amdgcn_global_load_lds((const unsigned*)((const char*)(gbase) + (voff)[_i]), (LAS unsigned*)(lds + (bufoff) + ldsw + _i * 8192), 16, 0, 0); } while (0)
#define PG8_LDA(dst, b, h) do { _Pragma("unroll") for (int m = 0; m < 4; ++m) _Pragma("unroll") for (int k = 0; k < 2; ++k) dst[m][k] = *(const LAS bf16x8*)(lds + PG8_SA(b, h) + aoff + m * 2048 + k * 1024); } while (0)
#define PG8_LDB(dst, b, h) do { _Pragma("unroll") for (int n = 0; n < 2; ++n) _Pragma("unroll") for (int k = 0; k < 2; ++k) dst[n][k] = *(const LAS bf16x8*)(lds + PG8_SB(b, h) + boff + n * 2048 + k * 1024); } while (0)
#define PG8_MMA(ai, bj, At, Bt) do { __builtin_amdgcn_s_setprio(1); _Pragma("unroll") for (int m = 0; m < 4; ++m) _Pragma("unroll") for (int n = 0; n < 2; ++n) _Pragma("unroll") for (int k = 0; k < 2; ++k) \
        acc[ai][bj][m][n] = __builtin_amdgcn_mfma_f32_16x16x32_bf16(Bt[n][k], At[m][k], acc[ai][bj][m][n], 0, 0, 0); __builtin_amdgcn_s_setprio(0); } while (0)
#define PG8_WAIT_V(n) asm volatile("s_waitcnt vmcnt(" #n ")" ::: "memory")
#define PG8_WAIT_L(n) asm volatile("s_waitcnt lgkmcnt(" #n ")" ::: "memory")
#define PG8_BAR __builtin_amdgcn_s_barrier()
#define PG8_SCHED __builtin_amdgcn_sched_barrier(0)
#define PG8_PTRS(u, pa, pb) do { const size_t _ko = (u).ks >= 0 ? (size_t)(u).ks * (size_t)(K / KSPLIT) * 2 : 0; \
        const char* _a = (const char*)g.A + (size_t)(u).pm * tstep + _ko; const char* _b = (const char*)g.Bt + (size_t)(u).pn * tstep + _ko; \
        if ((u).pn >= g.nN_main) { pa = _b; pb = _a; } else { pa = _a; pb = _b; } } while (0)
    Unit cur, nxt; int ui = 0;
    if (!S.next(0, cur)) return;
    f32x4 acc[2][2][4][2];
#pragma unroll
    for (int a = 0; a < 2; ++a)
#pragma unroll
        for (int b = 0; b < 2; ++b)
#pragma unroll
            for (int m = 0; m < 4; ++m)
#pragma unroll
                for (int n = 0; n < 2; ++n) acc[a][b][m][n] = (f32x4){0.f, 0.f, 0.f, 0.f};
    bf16x8 At[4][2], B0[2][2], B1[2][2];
    const char* cA; const char* cB; PG8_PTRS(cur, cA, cB);
    PG8_STAGE(PG8_SB(0, 0), cB, voffB); PG8_STAGE(PG8_SB(0, 1), cB + hstep, voffB); PG8_STAGE(PG8_SA(0, 0), cA, voffA); PG8_STAGE(PG8_SA(0, 1), cA + hstep, voffA);
    if (wr == 1) PG8_BAR;
    PG8_WAIT_V(2); PG8_BAR;
    PG8_STAGE(PG8_SB(1, 0), cB + kstep, voffB); PG8_STAGE(PG8_SA(1, 0), cA + kstep, voffA); PG8_STAGE(PG8_SB(1, 1), cB + hstep + kstep, voffB);
    PG8_WAIT_V(6); PG8_BAR;
    for (;;) {
        const bool has_next = S.next(ui + 1, nxt);
        const char* nA = cA; const char* nB = cB; if (has_next) PG8_PTRS(nxt, nA, nB);
        const int nt = (cur.ks >= 0) ? (K / KSPLIT) / BK : K / BK;
        for (int t = 0; t < nt; t += 2) {
            const bool last = (t == nt - 2);
            const char* a1 = cA + (size_t)(t + 1) * kstep;
            const char* a2 = last ? nA : cA + (size_t)(t + 2) * kstep; const char* b2 = last ? nB : cB + (size_t)(t + 2) * kstep;
            const char* a3 = a2 + kstep; const char* b3 = b2 + kstep;
            PG8_LDB(B0, 0, 0); PG8_LDB(B1, 0, 1); PG8_SCHED; PG8_LDA(At, 0, 0); PG8_STAGE(PG8_SA(1, 1), a1 + hstep, voffA);
            PG8_WAIT_V(8); PG8_WAIT_L(0); PG8_BAR; PG8_MMA(0, 0, At, B0); PG8_MMA(0, 1, At, B1); PG8_BAR; PG8_SCHED;
            PG8_LDA(At, 0, 1); PG8_STAGE(PG8_SB(0, 0), b2, voffB); PG8_STAGE(PG8_SB(0, 1), b2 + hstep, voffB); PG8_STAGE(PG8_SA(0, 0), a2, voffA);
            PG8_WAIT_V(8); PG8_WAIT_L(0); PG8_BAR; PG8_MMA(1, 0, At, B0); PG8_MMA(1, 1, At, B1); PG8_BAR; PG8_SCHED;
            PG8_LDB(B0, 1, 0); PG8_LDB(B1, 1, 1); PG8_SCHED; PG8_LDA(At, 1, 0); PG8_STAGE(PG8_SA(0, 1), a2 + hstep, voffA);
            PG8_WAIT_V(8); PG8_WAIT_L(0); PG8_BAR; PG8_MMA(0, 0, At, B0); PG8_MMA(0, 1, At, B1); PG8_BAR; PG8_SCHED;
            PG8_LDA(At, 1, 1); PG8_STAGE(PG8_SB(1, 0), b3, voffB); PG8_STAGE(PG8_SB(1, 1), b3 + hstep, voffB); PG8_STAGE(PG8_SA(1, 0), a3, voffA);
            PG8_WAIT_V(8); PG8_WAIT_L(0); PG8_BAR; PG8_MMA(1, 0, At, B0); PG8_MMA(1, 1, At, B1); PG8_BAR; PG8_SCHED;
        }
        if constexpr (ALIGN_EPI) { if (wr == 0) PG8_BAR; }
        E(acc, cur, wr, wc, fr, fq);
        if (!has_next) break;
#pragma unroll
        for (int a = 0; a < 2; ++a)
#pragma unroll
            for (int b = 0; b < 2; ++b)
#pragma unroll
                for (int m = 0; m < 4; ++m)
#pragma unroll
                    for (int n = 0; n < 2; ++n) acc[a][b][m][n] = (f32x4){0.f, 0.f, 0.f, 0.f};
        cur = nxt; cA = nA; cB = nB; ++ui;
        if constexpr (ALIGN_EPI) { if (wr == 1) PG8_BAR; }
    }
    PG8_WAIT_V(0);
    if constexpr (!ALIGN_EPI) { if (wr == 0) PG8_BAR; }
    PG8_BAR;
#undef PG8_SA
#undef PG8_SB
#undef PG8_STAGE
#undef PG8_LDA
#undef PG8_LDB
#undef PG8_MMA
#undef PG8_WAIT_V
#undef PG8_WAIT_L
#undef PG8_BAR
#undef PG8_SCHED
#undef PG8_PTRS
}
}

#define XB_TMO      128
#define XB_XCNT(j)  (256  + 64 * (j))
#define XB_XSUB(j)  (1280 + 64 * (j))
#define XB_XGEN(j)  (2304 + 64 * (j))
#define XB_TOP      3328
#define XB_TOPGEN   3392
#define XCD_BAR_WORDS 3456
#define XB_SPIN_CAP (1u << 18)
__device__ __forceinline__ unsigned xb_ld(unsigned* p)              { return __hip_atomic_load(p, __ATOMIC_RELAXED, __HIP_MEMORY_SCOPE_AGENT); }
__device__ __forceinline__ unsigned xb_add(unsigned* p, unsigned v) { return __hip_atomic_fetch_add(p, v, __ATOMIC_RELAXED, __HIP_MEMORY_SCOPE_AGENT); }
__device__ __forceinline__ unsigned xb_xcc_id() { return (unsigned)__builtin_amdgcn_s_getreg((3 << 11) | 20) & 0xFu; }
#define XB_SPIN(cond, bar) do { unsigned _sp = 0; while (cond) { __builtin_amdgcn_s_sleep(1); \
    if ((++_sp & 255u) == 0u) { if (xb_ld(&(bar)[XB_TMO])) break; if (_sp > XB_SPIN_CAP) { atomicAdd(&(bar)[XB_TMO], 1u); break; } } } } while (0)
struct XcdBarrier { unsigned* bar; unsigned x; volatile LAS unsigned* st; };
__device__ __forceinline__ XcdBarrier xcd_barrier_post(unsigned* bar, volatile LAS unsigned* st) {
    XcdBarrier b; b.bar = bar; b.x = xb_xcc_id(); b.st = st;
    if (threadIdx.x == 0) (void)xb_add(&bar[XB_XCNT(b.x)], 1u);
    return b;
}
__device__ __forceinline__ void xcd_barrier_complete(unsigned* bar, unsigned x, unsigned& nloc, unsigned& nx) {
    const unsigned G = gridDim.x * gridDim.y * gridDim.z;
    unsigned sum, cnt, mine, sp = 0u;
    for (;;) {
        sum = 0u; cnt = 0u; mine = 0u;
#pragma unroll
        for (unsigned j = 0; j < 16; ++j) { const unsigned c = xb_ld(&bar[XB_XCNT(j)]); sum += c; cnt += (c > 0u) ? 1u : 0u; mine = (j == x) ? c : mine; }
        if (sum == G) break;
        __builtin_amdgcn_s_sleep(1);
        if ((++sp & 255u) == 0u) { if (xb_ld(&bar[XB_TMO])) break; if (sp > XB_SPIN_CAP) { atomicAdd(&bar[XB_TMO], 1u); break; } }
    }
    nloc = mine > 0u ? mine : 1u; nx = cnt > 0u ? cnt : 1u;
}
__device__ __forceinline__ void xcd_barrier(const XcdBarrier& b) {
    asm volatile("s_waitcnt vmcnt(0)" ::: "memory");
    __syncthreads();
    if (threadIdx.x == 0) {
        unsigned* bar = b.bar;
        __builtin_amdgcn_s_waitcnt(0);
        unsigned nloc = b.st[0], nx = b.st[1];
        if (nloc == 0u) { xcd_barrier_complete(bar, b.x, nloc, nx); b.st[0] = nloc; b.st[1] = nx; }
        const unsigned old = xb_add(&bar[XB_XSUB(b.x)], 1u);
        const unsigned gen = old / nloc;
        if (old + 1u == (gen + 1u) * nloc) {
            __builtin_amdgcn_fence(__ATOMIC_RELEASE, "agent");
            asm volatile("s_waitcnt vmcnt(0)" ::: "memory");
            const unsigned og = xb_add(&bar[XB_TOP], 1u);
            const unsigned tg = og / nx;
            if (og + 1u == (tg + 1u) * nx) xb_add(&bar[XB_TOPGEN], 1u);
            else XB_SPIN(xb_ld(&bar[XB_TOPGEN]) == tg, bar);
            __builtin_amdgcn_fence(__ATOMIC_ACQUIRE, "agent");
            xb_add(&bar[XB_XGEN(b.x)], 1u);
            asm volatile("s_waitcnt vmcnt(0)" ::: "memory");
        } else {
            XB_SPIN(xb_ld(&bar[XB_XGEN(b.x)]) == gen, bar);
            __builtin_amdgcn_fence(__ATOMIC_ACQUIRE, "agent");
            asm volatile("s_waitcnt vmcnt(0)" ::: "memory");
        }
    }
    __syncthreads();
}

struct Params {
    const float* in[17];
    float* out; unsigned char* ws;
    int ph_lo, ph_hi;
};
enum { I_X = 0, I_C, I_CTX, I_CCTX, I_WMOD, I_BMOD, I_GPREMIX, I_GPOSTMIX, I_GPREMLP, I_GPOSTMLP, I_WIN, I_POOLW, I_POOLS, I_RPB, I_WOUT, I_W1, I_W2 };

__device__ __forceinline__ void transpose_item(const float* W, int ldw, bf16_t* WT, int ldt, int kofs, int nblk, LAS float* scr, int item, int lane) {
    const int kb = item / nblk, nb = item % nblk, k0 = 64 * kb, n0 = 32 * nb;
#pragma unroll 8
    for (int i = 0; i < 32; ++i) { const int kk = 2 * i + (lane >> 5); scr[kk * 33 + (lane & 31)] = W[(size_t)(k0 + kk) * ldw + n0 + (lane & 31)]; }
    LDS_WAIT(); asm volatile("" ::: "memory");
    const int c = lane & 7;
#pragma unroll
    for (int j = 0; j < 4; ++j) { const int n = (lane >> 3) + 8 * j; const LAS float* s = scr + (8 * c) * 33 + n;
        u32x4 o; o.x = cvt_pk_bf16(s[0 * 33], s[1 * 33]); o.y = cvt_pk_bf16(s[2 * 33], s[3 * 33]); o.z = cvt_pk_bf16(s[4 * 33], s[5 * 33]); o.w = cvt_pk_bf16(s[6 * 33], s[7 * 33]);
        *(u32x4*)(WT + (size_t)(n0 + n) * ldt + kofs + k0 + 8 * c) = o; }
    LDS_WAIT(); asm volatile("" ::: "memory");
}

__device__ __forceinline__ float silu_f(float v) { return v / (1.f + __expf(-v)); }

__device__ __forceinline__ void mod_item(const Params& p, LAS unsigned char* lds, int item, int tid, int wave, int lane) {
    LAS float* sv = (LAS float*)lds;
    LAS float* part = (LAS float*)(lds + 36864);
    const int l = item / 24, j0 = (item % 24) * 256;
    for (int i = tid; i < 9 * 1024; i += NTHR) { const int r = i >> 10, k = i & 1023; const float v = (r < 8) ? p.in[I_C][r * 1024 + k] : p.in[I_CCTX][k]; sv[i] = silu_f(v); }
    __syncthreads();
    f32x4 acc[9];
#pragma unroll
    for (int r = 0; r < 9; ++r) acc[r] = (f32x4){0.f, 0.f, 0.f, 0.f};
    const float* wp = p.in[I_WMOD] + (size_t)l * DM * NMOD + (size_t)(wave * 128) * NMOD + j0 + 4 * lane;
#pragma unroll 1
    for (int k8 = 0; k8 < 128; k8 += 8) {
        f32x4 wv[8];
#pragma unroll
        for (int u = 0; u < 8; ++u) wv[u] = *(const f32x4*)(wp + (size_t)(k8 + u) * NMOD);
#pragma unroll
        for (int u = 0; u < 8; ++u)
#pragma unroll
            for (int r = 0; r < 9; ++r) { const float s = sv[r * 1024 + wave * 128 + k8 + u]; acc[r] += wv[u] * s; }
    }
#pragma unroll
    for (int r = 0; r < 9; ++r) *(LAS f32x4*)(part + (wave * 9 + r) * 256 + 4 * lane) = acc[r];
    __syncthreads();
    float* mod = (float*)(p.ws + WS_MOD) + (size_t)l * 9 * NMOD;
    for (int i = tid; i < 9 * 256; i += NTHR) { const int r = i >> 8, j = i & 255; float s = p.in[I_BMOD][l * NMOD + j0 + j];
#pragma unroll
        for (int w = 0; w < 8; ++w) s += part[(w * 9 + r) * 256 + j];
        mod[r * NMOD + j0 + j] = s; }
    __syncthreads();
}

__device__ __forceinline__ void weff_item(const Params& p, LAS unsigned char* lds, int item, int tid, int wave, int lane) {
    LAS float* pw = (LAS float*)lds;
    LAS float* wo = (LAS float*)(lds + 128 * 129 * 4);
    const int l = item >> 6, g = (item >> 4) & 3, n0 = (item & 15) * 64;
    const float* pwg = p.in[I_POOLW] + ((size_t)l * 4 + g) * 128 * 128;
    for (int i = tid; i < 128 * 128; i += NTHR) pw[(i >> 7) * 129 + (i & 127)] = pwg[i];
    const float* wog = p.in[I_WOUT] + (size_t)l * DM * DM + (size_t)(g * 128) * DM + n0;
    const float* psg = p.in[I_POOLS] + l * 512 + g * 128;
    for (int i = tid; i < 128 * 64; i += NTHR) { const int d = i >> 6, n = i & 63; wo[i] = wog[(size_t)d * DM + n] * psg[d]; }
    __syncthreads();
    float acc[16];
#pragma unroll
    for (int c = 0; c < 16; ++c) acc[c] = 0.f;
    const int n = lane, cb = wave * 16;
#pragma unroll 4
    for (int d = 0; d < 128; ++d) { const float w = wo[d * 64 + n];
#pragma unroll
        for (int c = 0; c < 16; ++c) acc[c] += pw[(cb + c) * 129 + d] * w; }
    bf16_t* dst = (bf16_t*)(p.ws + WS_WOUT) + (size_t)l * DM * DM + (size_t)(n0 + n) * DM + g * 128 + cb;
    u32x4 o0, o1;
    o0.x = cvt_pk_bf16(acc[0], acc[1]); o0.y = cvt_pk_bf16(acc[2], acc[3]); o0.z = cvt_pk_bf16(acc[4], acc[5]); o0.w = cvt_pk_bf16(acc[6], acc[7]);
    o1.x = cvt_pk_bf16(acc[8], acc[9]); o1.y = cvt_pk_bf16(acc[10], acc[11]); o1.z = cvt_pk_bf16(acc[12], acc[13]); o1.w = cvt_pk_bf16(acc[14], acc[15]);
    *(u32x4*)dst = o0; *(u32x4*)(dst + 8) = o1;
    __syncthreads();
}

__device__ __forceinline__ void phase_prologue(const Params& p, LAS unsigned char* lds, int G, int tid, int wave, int lane) {
    for (int it = blockIdx.x; it < DEPTH * 24; it += G) mod_item(p, lds, it, tid, wave, lane);
    for (int it = blockIdx.x; it < DEPTH * 64; it += G) weff_item(p, lds, it, tid, wave, lane);
    LAS float* scr = (LAS float*)(lds + wave * 16384);
    const int gw = blockIdx.x * NWAVES + wave, NGW = G * NWAVES;
    constexpr int I_IN = 16 * 64, I_O = 8 * 32, I_1 = 16 * 128, I_2 = 64 * 32, I_L = I_IN + I_O + I_1 + I_2;
    for (int it = gw; it < DEPTH * I_L; it += NGW) {
        const int l = it / I_L; int r = it % I_L;
        if (r < I_IN) { transpose_item(p.in[I_WIN] + (size_t)l * DM * NIN, NIN, (bf16_t*)(p.ws + WS_WIN) + (size_t)l * NIN * DM, DM, 0, NIN / 32, scr, r, lane); continue; } r -= I_IN;
        if (r < I_O) { transpose_item(p.in[I_WOUT] + (size_t)l * DM * DM + (size_t)512 * DM, DM, (bf16_t*)(p.ws + WS_WOUT) + (size_t)l * DM * DM, DM, 512, DM / 32, scr, r, lane); continue; } r -= I_O;
        if (r < I_1) { transpose_item(p.in[I_W1] + (size_t)l * DM * FF, FF, (bf16_t*)(p.ws + WS_W1) + (size_t)l * FF * DM, DM, 0, FF / 32, scr, r, lane); continue; } r -= I_1;
        transpose_item(p.in[I_W2] + (size_t)l * FF * DM, DM, (bf16_t*)(p.ws + WS_W2) + (size_t)l * DM * FF, FF, 0, DM / 32, scr, r, lane);
    }
}

struct RowArgs {
    const void* xlat; const void* xctx; bool xin_f32;
    void* olat; void* octx; bool xout_f32;
    const float* gpost; const float* mod_cur;
    int gate_off;
    const float* gpre; const float* mod_nxt; int sh_off, sc_off;
    int nrows; bool has_y, write_xn, ctx_split;
};
__device__ __forceinline__ f32x4 bfx4_lo(u32x4 w) { return (f32x4){bf_lo(w.x), bf_hi(w.x), bf_lo(w.y), bf_hi(w.y)}; }
__device__ __forceinline__ f32x4 bfx4_hi(u32x4 w) { return (f32x4){bf_lo(w.z), bf_hi(w.z), bf_lo(w.w), bf_hi(w.w)}; }
__device__ __forceinline__ void phase_rows(const Params& p, const RowArgs& a, int G, int wave, int lane) {
    bf16_t* XN = (bf16_t*)(p.ws + WS_XN);
    const int gw = blockIdx.x * NWAVES + wave, NGW = G * NWAVES;
    f32x4 gpo[4], gpr[4];
#pragma unroll
    for (int j = 0; j < 4; ++j) { const int c = 8 * lane + 512 * (j >> 1) + 4 * (j & 1);
        gpo[j] = a.has_y ? *(const f32x4*)(a.gpost + c) : (f32x4){0.f, 0.f, 0.f, 0.f};
        gpr[j] = a.write_xn ? *(const f32x4*)(a.gpre + c) : (f32x4){0.f, 0.f, 0.f, 0.f}; }
#pragma unroll 1
    for (int mp = gw; mp < a.nrows / 2; mp += NGW) {
        const int m0 = 2 * mp; const bool isl = m0 < ML; const int rb = isl ? (m0 >> 12) : 8;
        const size_t xoff = isl ? (size_t)m0 * DM : (size_t)(m0 - ML) * DM;
        const void* xrb = isl ? a.xlat : a.xctx; void* xob = isl ? a.olat : a.octx;
        bf16_t* xn = XN + (size_t)m0 * DM;
        const size_t moff = (size_t)rb * NMOD;
        f32x4 v[2][4], y[2][4], gt[4], sh[4], sc[4];
        if (a.xin_f32) {
#pragma unroll
            for (int u = 0; u < 2; ++u)
#pragma unroll
                for (int j = 0; j < 4; ++j) v[u][j] = *(const f32x4*)((const float*)xrb + xoff + u * DM + 8 * lane + 512 * (j >> 1) + 4 * (j & 1));
        } else {
#pragma unroll
            for (int u = 0; u < 2; ++u)
#pragma unroll
                for (int jb = 0; jb < 2; ++jb) { const u32x4 xw = *(const u32x4*)((const bf16_t*)xrb + xoff + u * DM + 8 * lane + 512 * jb); v[u][2 * jb] = bfx4_lo(xw); v[u][2 * jb + 1] = bfx4_hi(xw); }
        }
        if (a.has_y) {
            if (isl || !a.ctx_split) {
#pragma unroll
                for (int u = 0; u < 2; ++u)
#pragma unroll
                    for (int jb = 0; jb < 2; ++jb) { const u32x4 yw = *(const u32x4*)(xn + u * DM + 8 * lane + 512 * jb); y[u][2 * jb] = bfx4_lo(yw); y[u][2 * jb + 1] = bfx4_hi(yw); }
            } else {
                const float* part = (const float*)p.out;
#pragma unroll
                for (int u = 0; u < 2; ++u)
#pragma unroll
                    for (int j = 0; j < 4; ++j) { const float* pp = part + (size_t)(m0 + u - ML) * DM + 8 * lane + 512 * (j >> 1) + 4 * (j & 1); f32x4 s = *(const f32x4*)pp;
#pragma unroll
                        for (int k = 1; k < pg8::KSPLIT; ++k) s += *(const f32x4*)(pp + (size_t)k * MC * DM);
                        y[u][j] = s; }
            }
#pragma unroll
            for (int j = 0; j < 4; ++j) gt[j] = *(const f32x4*)(a.mod_cur + moff + a.gate_off + 8 * lane + 512 * (j >> 1) + 4 * (j & 1));
        }
        if (a.write_xn) {
#pragma unroll
            for (int j = 0; j < 4; ++j) { const int c = 8 * lane + 512 * (j >> 1) + 4 * (j & 1); sh[j] = *(const f32x4*)(a.mod_nxt + moff + a.sh_off + c); sc[j] = *(const f32x4*)(a.mod_nxt + moff + a.sc_off + c); }
        }
        __builtin_amdgcn_sched_barrier(0);
        if (a.has_y) {
#pragma unroll
            for (int u = 0; u < 2; ++u) {
                float s = 0.f;
#pragma unroll
                for (int j = 0; j < 4; ++j) s += (y[u][j][0] * y[u][j][0] + y[u][j][1] * y[u][j][1]) + (y[u][j][2] * y[u][j][2] + y[u][j][3] * y[u][j][3]);
                const float rstd = rsqrtf(wave_sum(s) * (1.f / DM) + EPS);
#pragma unroll
                for (int j = 0; j < 4; ++j) v[u][j] = v[u][j] + gt[j] * (y[u][j] * rstd * gpo[j]);
                if (a.xout_f32) {
#pragma unroll
                    for (int j = 0; j < 4; ++j) *(f32x4*)((float*)xob + xoff + u * DM + 8 * lane + 512 * (j >> 1) + 4 * (j & 1)) = v[u][j];
                } else {
#pragma unroll
                    for (int jb = 0; jb < 2; ++jb) { u32x4 w; w.x = cvt_pk_bf16(v[u][2 * jb][0], v[u][2 * jb][1]); w.y = cvt_pk_bf16(v[u][2 * jb][2], v[u][2 * jb][3]);
                        w.z = cvt_pk_bf16(v[u][2 * jb + 1][0], v[u][2 * jb + 1][1]); w.w = cvt_pk_bf16(v[u][2 * jb + 1][2], v[u][2 * jb + 1][3]);
                        *(u32x4*)((bf16_t*)xob + xoff + u * DM + 8 * lane + 512 * jb) = w; v[u][2 * jb] = bfx4_lo(w); v[u][2 * jb + 1] = bfx4_hi(w); }
                } }
        }
        if (a.write_xn) {
#pragma unroll
            for (int u = 0; u < 2; ++u) {
                float s2 = 0.f;
#pragma unroll
                for (int j = 0; j < 4; ++j) s2 += (v[u][j][0] * v[u][j][0] + v[u][j][1] * v[u][j][1]) + (v[u][j][2] * v[u][j][2] + v[u][j][3] * v[u][j][3]);
                const float rstd = rsqrtf(wave_sum(s2) * (1.f / DM) + EPS);
#pragma unroll
                for (int jb = 0; jb < 2; ++jb) { const f32x4 h0 = (v[u][2 * jb] * rstd * gpr[2 * jb]) * (sc[2 * jb] + 1.f) + sh[2 * jb], h1 = (v[u][2 * jb + 1] * rstd * gpr[2 * jb + 1]) * (sc[2 * jb + 1] + 1.f) + sh[2 * jb + 1];
                    u32x4 w; w.x = cvt_pk_bf16(h0[0], h0[1]); w.y = cvt_pk_bf16(h0[2], h0[3]); w.z = cvt_pk_bf16(h1[0], h1[1]); w.w = cvt_pk_bf16(h1[2], h1[3]);
                    *(u32x4*)(xn + u * DM + 8 * lane + 512 * jb) = w; } }
        }
    }
}

constexpr float LOG2E = 1.4426950408889634f;
constexpr int RPB_PITCH = 64, RPB_OFF = 16;

constexpr int AT_KC = 0, AT_VC = 32768;
constexpr int AT_KL = 0, AT_VL = 73728, AT_VLP = 1280, AT_RPB = AT_VL + 64 * AT_VLP;
static_assert(AT_RPB + 15 * 64 * 4 <= LDS_BYTES - 16, "attention LDS map");
__device__ __forceinline__ int kswz(int key) { return ((key >> 1) & 1) | (((key >> 3) & 3) << 1); }

template <bool LOC>
__device__ __forceinline__ void attn_half(const LAS unsigned char* lds, int kaddr0, int kaddr1, int kcs, int vrow, int vchunk0, int vcs, int vpitch_dt,
                                          const LAS float* bp, int elo, const bf16x8 q0, const bf16x8 q1, float& mx, float& lsum, f32x4 (&o)[4], int g, int qi) {
    constexpr float SC = 0.125f * LOG2E;
    float s[8][8];
    bf16x8 kf[2][4];
#define AH_LDK(c, bufi) do { kf[bufi][0] = *(const LAS bf16x8*)(lds + kaddr0 + (c) * kcs); kf[bufi][1] = *(const LAS bf16x8*)(lds + kaddr1 + (c) * kcs); \
        kf[bufi][2] = *(const LAS bf16x8*)(lds + kaddr0 + (c) * kcs + 512); kf[bufi][3] = *(const LAS bf16x8*)(lds + kaddr1 + (c) * kcs + 512); } while (0)
    AH_LDK(0, 0);
#pragma unroll
    for (int c = 0; c < 8; ++c) {
        if (c < 7) AH_LDK(c + 1, (c + 1) & 1);
        __builtin_amdgcn_sched_barrier(0);
        f32x4 t0 = (f32x4){0.f, 0.f, 0.f, 0.f}, t1 = (f32x4){0.f, 0.f, 0.f, 0.f};
        t0 = __builtin_amdgcn_mfma_f32_16x16x32_bf16(kf[c & 1][0], q0, t0, 0, 0, 0); t1 = __builtin_amdgcn_mfma_f32_16x16x32_bf16(kf[c & 1][2], q0, t1, 0, 0, 0);
        t0 = __builtin_amdgcn_mfma_f32_16x16x32_bf16(kf[c & 1][1], q1, t0, 0, 0, 0); t1 = __builtin_amdgcn_mfma_f32_16x16x32_bf16(kf[c & 1][3], q1, t1, 0, 0, 0);
#pragma unroll
        for (int e = 0; e < 8; ++e) { const float a = (e < 4) ? t0[e] : t1[e - 4];
            if (LOC) { const float bv = bp[c * RPB_PITCH + e]; const bool ok = (e >= elo) && (e < elo + 16); s[c][e] = ok ? (a * SC + bv) : -INFINITY; }
            else s[c][e] = a * SC; }
        __builtin_amdgcn_sched_barrier(0);
    }
#undef AH_LDK
    float m2 = mx;
#pragma unroll
    for (int c = 0; c < 8; ++c)
#pragma unroll
        for (int e = 0; e < 8; ++e) m2 = fmaxf(m2, s[c][e]);
    m2 = fmaxf(m2, __shfl_xor(m2, 16)); m2 = fmaxf(m2, __shfl_xor(m2, 32));
    const float alpha = __builtin_amdgcn_exp2f(mx - m2);
    mx = m2; lsum *= alpha;
#pragma unroll
    for (int dt = 0; dt < 4; ++dt) o[dt] = o[dt] * alpha;
    bf16x8 vf[2][4];
#define AH_LDV(c, bufi) do { const int vaddr = vrow + (((vchunk0 + (c) * vcs + g) ^ qi) << 4); _Pragma("unroll") for (int dt = 0; dt < 4; ++dt) vf[bufi][dt] = *(const LAS bf16x8*)(lds + vaddr + dt * vpitch_dt); } while (0)
    AH_LDV(0, 0);
#pragma unroll
    for (int c = 0; c < 8; ++c) {
        if (c < 7) AH_LDV(c + 1, (c + 1) & 1);
        __builtin_amdgcn_sched_barrier(0);
        float pe[8];
#pragma unroll
        for (int e = 0; e < 8; ++e) { pe[e] = __builtin_amdgcn_exp2f(s[c][e] - mx); lsum += pe[e]; }
        u32x4 pw; pw.x = cvt_pk_bf16(pe[0], pe[1]); pw.y = cvt_pk_bf16(pe[2], pe[3]); pw.z = cvt_pk_bf16(pe[4], pe[5]); pw.w = cvt_pk_bf16(pe[6], pe[7]);
        const bf16x8 pb = __builtin_bit_cast(bf16x8, pw);
#pragma unroll
        for (int dt = 0; dt < 4; ++dt) o[dt] = __builtin_amdgcn_mfma_f32_16x16x32_bf16(vf[c & 1][dt], pb, o[dt], 0, 0, 0);
        __builtin_amdgcn_sched_barrier(0);
    }
#undef AH_LDV
}

__device__ __forceinline__ void attn_store(bf16_t* MIX, int qtok, int h, int g, float lsum, const f32x4 (&o)[4]) {
    lsum += __shfl_xor(lsum, 16); lsum += __shfl_xor(lsum, 32);
    const float inv = 1.f / lsum;
    bf16_t* op = MIX + (size_t)qtok * DM + 512 + h * 64 + 4 * g;
#pragma unroll
    for (int dt = 0; dt < 4; ++dt) { u32x2 w; w.x = cvt_pk_bf16(o[dt][0] * inv, o[dt][1] * inv); w.y = cvt_pk_bf16(o[dt][2] * inv, o[dt][3] * inv); *(u32x2*)(op + 16 * dt) = w; }
}

__device__ __forceinline__ void phase_mixer(const Params& p, LAS unsigned char* lds, int l, bool with_ctx, int G, int tid, int wave, int lane, int rep_attn, int rep_pool) {
    const bf16_t* PB = (const bf16_t*)(p.ws + WS_PB); const bf16_t* VT = (const bf16_t*)(p.ws + WS_VT); bf16_t* MIX = (bf16_t*)(p.ws + WS_MIX);
    const int gw = blockIdx.x * NWAVES + wave, NGW = G * NWAVES;
    const int qi = lane & 15, g = lane >> 4, kap = 8 * (qi >> 2) + (qi & 3);
#pragma unroll 1
    for (int ra = 0; ra < rep_attn; ++ra)
#pragma unroll 1
    for (int I = blockIdx.x; I < 64 * 32; I += G) {
        const int x = I & 7, t = I >> 3, j = t & 31, rho = t >> 5, pr = rho * 8 + x, b = pr >> 3, h = pr & 7;
        const int r0 = 2 * j, rs0 = min(max(r0 - 4, 0), 56);
        const int r = r0 + (wave >> 2), n = wave & 3, rs = min(max(r - 4, 0), 56), kc0 = min(max(16 * n - 8, 0), 32);
        const int qc = 16 * n + qi, qs = min(max(qc - 8, 0), 48);
        const int sel = (j - 2 * rho) & 31;
        const int npass = (with_ctx && sel < 2) ? 2 : 1;
        {
            u32x4 kreg[4], vreg[4];
            const bf16_t* ksrc = PB + (size_t)(ML + b * CT + (tid >> 3)) * PBW + 1024 + h * 64 + (tid & 7) * 8;
            const bf16_t* vsrc = VT + (size_t)(h * 64 + (tid >> 5)) * VTP + ML + b * CT + (tid & 31) * 8;
#pragma unroll
            for (int ps = 0; ps < 4; ++ps) { kreg[ps] = *(const u32x4*)(ksrc + (size_t)(ps * 64) * PBW); vreg[ps] = *(const u32x4*)(vsrc + (size_t)(ps * 16) * VTP); }
            __builtin_amdgcn_sched_barrier(0);
#pragma unroll
            for (int ps = 0; ps < 4; ++ps) { const int key = ps * 64 + (tid >> 3), d = ps * 16 + (tid >> 5);
                *(LAS u32x4*)(lds + AT_KC + key * 128 + ((((tid & 7) ^ kswz(key))) << 4)) = kreg[ps];
                *(LAS u32x4*)(lds + AT_VC + d * 512 + ((((tid & 31) ^ (d & 15))) << 4)) = vreg[ps]; }
        }
        __syncthreads();
        float mxA = -INFINITY, lA = 0.f; f32x4 oA[4]; bf16x8 qA0, qA1;
        {
            const int kl = kap, ka0 = AT_KC + kl * 128 + ((g ^ kswz(kl)) << 4), ka1 = AT_KC + kl * 128 + (((g + 4) ^ kswz(kl)) << 4);
            const int vrow = AT_VC + qi * 512;
#pragma unroll 1
            for (int ps = 2 - npass; ps < 2; ++ps) {
                const int qtok = (ps == 1) ? (b * SEQ + r * 64 + 16 * n + qi) : (ML + b * CT + 16 * (sel * 8 + wave) + qi);
                const bf16_t* qp = PB + (size_t)qtok * PBW + 512 + h * 64 + 8 * g;
                qA0 = *(const bf16x8*)qp; qA1 = *(const bf16x8*)(qp + 32);
                mxA = -INFINITY; lA = 0.f;
#pragma unroll
                for (int dt = 0; dt < 4; ++dt) oA[dt] = (f32x4){0.f, 0.f, 0.f, 0.f};
                attn_half<false>(lds, ka0, ka1, 32 * 128, vrow, 0, 4, 16 * 512, nullptr, 0, qA0, qA1, mxA, lA, oA, g, qi);
                if (ps == 0) attn_store(MIX, qtok, h, g, lA, oA);
            }
        }
        __syncthreads();
        {
            const int tok0 = b * SEQ + rs0 * 64;
            const bf16_t* ksrc = PB + (size_t)(tok0 + (tid >> 3)) * PBW + 1024 + h * 64 + (tid & 7) * 8;
            u32x4 kreg[9], vreg[9];
#pragma unroll
            for (int ps = 0; ps < 9; ++ps) { const int idx = ps * 512 + tid, d = idx / 72, ch = idx - d * 72;
                kreg[ps] = *(const u32x4*)(ksrc + (size_t)(ps * 64) * PBW);
                vreg[ps] = *(const u32x4*)(VT + (size_t)(h * 64 + d) * VTP + tok0 + ch * 8); }
            __builtin_amdgcn_sched_barrier(0);
#pragma unroll
            for (int ps = 0; ps < 9; ++ps) { const int key = ps * 64 + (tid >> 3), idx = ps * 512 + tid, d = idx / 72, ch = idx - d * 72;
                *(LAS u32x4*)(lds + AT_KL + key * 128 + ((((tid & 7) ^ kswz(key))) << 4)) = kreg[ps];
                *(LAS u32x4*)(lds + AT_VL + d * AT_VLP + ((ch ^ (d & 15)) << 4)) = vreg[ps]; }
            LAS float* rp = (LAS float*)(lds + AT_RPB);
            for (int i = tid; i < 15 * RPB_PITCH; i += NTHR) { const int row = i >> 6, cc = (i & 63) - RPB_OFF; rp[i] = (cc >= 0 && cc < 31) ? p.in[I_RPB][(size_t)(l * 8 + h) * 15 * 31 + row * 31 + cc] * LOG2E : 0.f; }
        }
        __syncthreads();
        {
            const int kl = (rs - rs0) * 64 + kc0 + kap, ka0 = AT_KL + kl * 128 + ((g ^ kswz(kl)) << 4), ka1 = AT_KL + kl * 128 + (((g + 4) ^ kswz(kl)) << 4);
            const int vrow = AT_VL + qi * AT_VLP, vch0 = (rs - rs0) * 8 + (kc0 >> 3);
            const LAS float* bp = (const LAS float*)(lds + AT_RPB) + (rs - r + 7) * RPB_PITCH + RPB_OFF + (kc0 + 8 * g - qc + 15);
            attn_half<true>(lds, ka0, ka1, 64 * 128, vrow, vch0, 8, 16 * AT_VLP, bp, qs - kc0 - 8 * g, qA0, qA1, mxA, lA, oA, g, qi);
            attn_store(MIX, b * SEQ + r * 64 + 16 * n + qi, h, g, lA, oA);
        }
        __syncthreads();
    }
    const int nrun = (with_ctx ? MT : ML) / 16;
    const int grp = lane >> 4, lo = 1 << grp, hi = lo - 1;
#pragma unroll 1
    for (int rp = 0; rp < rep_pool; ++rp)
#pragma unroll 1
    for (int run = gw; run < nrun; run += NGW) {
        const int tok0 = run * 16; const bool isl = tok0 < ML;
        const int base = isl ? (tok0 & ~(SEQ - 1)) : (ML + ((tok0 - ML) & ~(CT - 1))), len = isl ? SEQ : CT, t0 = tok0 - base;
        u32x4 w[31];
#pragma unroll
        for (int i = 0; i < 31; ++i) { const int tt = min(max(t0 - 8 + i, 0), len - 1); w[i] = *(const u32x4*)(PB + (size_t)(base + tt) * PBW + 8 * lane); }
#pragma unroll
        for (int o = 0; o < 16; ++o) {
            const int t = t0 + o, st = max(t - lo, 0), en = min(t + hi + 1, len);
            float acc[8];
#pragma unroll
            for (int e = 0; e < 8; ++e) acc[e] = 0.f;
#pragma unroll
            for (int i = 0; i < 16; ++i) { const int tt = t + i - 8; const float wt = (tt >= st && tt < en) ? 1.f : 0.f; const u32x4 ww = w[o + i];
                acc[0] += wt * bf_lo(ww.x); acc[1] += wt * bf_hi(ww.x); acc[2] += wt * bf_lo(ww.y); acc[3] += wt * bf_hi(ww.y);
                acc[4] += wt * bf_lo(ww.z); acc[5] += wt * bf_hi(ww.z); acc[6] += wt * bf_lo(ww.w); acc[7] += wt * bf_hi(ww.w); }
            const float ic = 1.f / (float)(en - st);
            const u32x4 sw = w[o + 8];
            u32x4 ov; ov.x = cvt_pk_bf16(acc[0] * ic - bf_lo(sw.x), acc[1] * ic - bf_hi(sw.x)); ov.y = cvt_pk_bf16(acc[2] * ic - bf_lo(sw.y), acc[3] * ic - bf_hi(sw.y));
            ov.z = cvt_pk_bf16(acc[4] * ic - bf_lo(sw.z), acc[5] * ic - bf_hi(sw.z)); ov.w = cvt_pk_bf16(acc[6] * ic - bf_lo(sw.w), acc[7] * ic - bf_hi(sw.w));
            *(u32x4*)(MIX + (size_t)(tok0 + o) * DM + 8 * lane) = ov;
        }
    }
    __syncthreads();
}

constexpr int NPHASE = 2 + 7 * DEPTH;
__global__ void __launch_bounds__(NTHR) fwd_kernel(Params p) {
    extern __shared__ __attribute__((aligned(16))) unsigned char lds_raw[];
    LAS unsigned char* lds = (LAS unsigned char*)lds_raw;
    const int G = gridDim.x;
    const int ph_hi = p.ph_hi;
    volatile LAS unsigned* xst = (volatile LAS unsigned*)(lds + LDS_BYTES - 16);
    if (threadIdx.x < 4) xst[threadIdx.x] = 0u;
    unsigned* const xbar = (unsigned*)(p.ws + WS_BAR);
    if (blockIdx.x == 0) for (int i = threadIdx.x; i < XCD_BAR_WORDS; i += NTHR) __hip_atomic_store(&xbar[i], 0u, __ATOMIC_RELAXED, __HIP_MEMORY_SCOPE_AGENT);
    __syncthreads();
    XcdBarrier xb; xb.bar = xbar; xb.x = 0; xb.st = xst;
    bool xb_posted = false;
    for (int ph = p.ph_lo; ph < ph_hi; ++ph) {
#if PROBE_DUP
        int ptype = -1; if (ph == 0) ptype = 0; else if (ph >= 2) { const int s_ = (ph - 2) % 7; ptype = (s_ == 0) ? 2 : (s_ == 1) ? 1 : (s_ == 2) ? 3 : (s_ == 4) ? 4 : (s_ == 5) ? 5 : -1; }
        const int nrep = (ptype >= 0 && ((PROBE_DUP >> ptype) & 1)) ? 2 : 1;
        for (int rep = 0; rep < nrep; ++rep) {
        if (rep) __syncthreads();
#endif
        int z = 0; asm volatile("s_mov_b32 %0, 0" : "=s"(z));
        Params q;
#pragma unroll
        for (int i = 0; i < 17; ++i) q.in[i] = p.in[i] + z;
        q.out = p.out + z; q.ws = p.ws + z; q.ph_lo = 0; q.ph_hi = 0;
        const int tid = threadIdx.x + z, lane = tid & 63, wave = __builtin_amdgcn_readfirstlane(tid >> 6);
        const float* mod = (const float*)(q.ws + WS_MOD);
        bf16_t* XN = (bf16_t*)(q.ws + WS_XN);
        bf16_t* ctxr = (bf16_t*)(q.ws + WS_CTXR); bf16_t* xres = (bf16_t*)(q.ws + WS_XR);
        if (ph == 0) phase_prologue(q, lds, G, tid, wave, lane);
        else if (ph == 1) {
            RowArgs a{}; a.xlat = q.in[I_X]; a.xctx = q.in[I_CTX]; a.xin_f32 = true; a.nrows = MT; a.has_y = false; a.write_xn = true;
            a.gpre = q.in[I_GPREMIX]; a.mod_nxt = mod; a.sh_off = 0; a.sc_off = DM;
            phase_rows(q, a, G, wave, lane);
        } else {
            const int l = (ph - 2) / 7, s = (ph - 2) % 7; const bool last = (l == DEPTH - 1);
            const int nMrows = last ? ML / 256 : MT / 256;
            if (s == 0) {
                pg8::Gemm g{XN, (const bf16_t*)(q.ws + WS_WIN) + (size_t)l * NIN * DM, DM, 6};
                pg8::StaticOrder S; S.init(MT / 256, 8, G, (int)blockIdx.x);
                pg8::Epi<0> E{(bf16_t*)(q.ws + WS_PB), (bf16_t*)(q.ws + WS_VT), nullptr};
                pg8::gemm_phase<pg8::Epi<0>, true>(lds, g, S, E, tid);
            } else if (s == 1) {
                phase_mixer(q, lds, l, !last, G, tid, wave, lane, 1 + ((PROBE_DUP >> 8) & 1), 1 + ((PROBE_DUP >> 6) & 1));
            } else if (s == 2) {
                pg8::Gemm g{(const bf16_t*)(q.ws + WS_MIX), (const bf16_t*)(q.ws + WS_WOUT) + (size_t)l * DM * DM, DM, 1 << 30};
                pg8::StaticOrder S; S.init(ML / 256, 4, G, (int)blockIdx.x, last ? 0 : MC / 256);
                pg8::Epi<1> E{XN, nullptr, q.out};
                pg8::gemm_phase<pg8::Epi<1>, true>(lds, g, S, E, tid);
            } else if (s == 3) {
                RowArgs a{}; a.xlat = (l == 0) ? (const void*)q.in[I_X] : (const void*)xres; a.xctx = (l == 0) ? (const void*)q.in[I_CTX] : (const void*)ctxr; a.xin_f32 = (l == 0); a.olat = xres; a.octx = ctxr; a.xout_f32 = false;
                a.gpost = q.in[I_GPOSTMIX] + l * DM; a.mod_cur = mod + (size_t)l * 9 * NMOD; a.gate_off = 2 * DM;
                a.gpre = q.in[I_GPREMLP] + l * DM; a.mod_nxt = a.mod_cur; a.sh_off = 3 * DM; a.sc_off = 4 * DM;
                a.nrows = nMrows * 256; a.has_y = true; a.write_xn = true; a.ctx_split = true;
                phase_rows(q, a, G, wave, lane);
            } else if (s == 4) {
                pg8::Gemm g{XN, (const bf16_t*)(q.ws + WS_W1) + (size_t)l * FF * DM, DM, 1 << 30};
                pg8::StaticOrder S; S.init(nMrows, 16, G, (int)blockIdx.x);
                pg8::Epi<2> E{(bf16_t*)(q.ws + WS_H), nullptr, nullptr};
                pg8::gemm_phase<pg8::Epi<2>, true>(lds, g, S, E, tid);
            } else if (s == 5) {
                pg8::Gemm g{(const bf16_t*)(q.ws + WS_H), (const bf16_t*)(q.ws + WS_W2) + (size_t)l * DM * FF, FF, 1 << 30};
                pg8::StaticOrder S; S.init(ML / 256, 4, G, (int)blockIdx.x, last ? 0 : MC / 256);
                pg8::Epi<1> E{XN, nullptr, q.out};
                pg8::gemm_phase<pg8::Epi<1>, true>(lds, g, S, E, tid);
            } else {
                RowArgs a{}; a.xlat = xres; a.xctx = ctxr; a.xin_f32 = false; a.olat = last ? (void*)q.out : (void*)xres; a.octx = ctxr; a.xout_f32 = last;
                a.gpost = q.in[I_GPOSTMLP] + l * DM; a.mod_cur = mod + (size_t)l * 9 * NMOD; a.gate_off = 5 * DM;
                a.nrows = nMrows * 256; a.has_y = true; a.write_xn = !last; a.ctx_split = true;
                if (!last) { a.gpre = q.in[I_GPREMIX] + (l + 1) * DM; a.mod_nxt = mod + (size_t)(l + 1) * 9 * NMOD; a.sh_off = 0; a.sc_off = DM; }
                phase_rows(q, a, G, wave, lane);
            }
        }
#if PROBE_DUP
        }
#endif
        if (ph + 1 < ph_hi) {
            if (!xb_posted) { cg::this_grid().sync(); xb = xcd_barrier_post(xbar, xst); xb_posted = true; }
            else { xcd_barrier(xb); if (PROBE_DUP & 128) xcd_barrier(xb); }
        }
    }
}

extern "C" void kernel_launch(void* const* d_in, const int* in_sizes, int n_in, void* d_out, int out_size, void* d_ws, size_t ws_size, hipStream_t stream) {
    static int grid = 0;
    if (grid == 0) {
        if (n_in != 17 || in_sizes[0] != ML * DM || out_size != ML * DM || ws_size < WS_END) { fprintf(stderr, "kernel_launch: unexpected shapes (n_in %d, in0 %d, out %d, ws %zu)\n", n_in, n_in > 0 ? in_sizes[0] : -1, out_size, ws_size); grid = -1; return; }
        int dev = 0, cus = 0, per_cu = 0;
        (void)hipGetDevice(&dev);
        (void)hipDeviceGetAttribute(&cus, hipDeviceAttributeMultiprocessorCount, dev);
        if (hipFuncSetAttribute((const void*)fwd_kernel, hipFuncAttributeMaxDynamicSharedMemorySize, LDS_BYTES) != hipSuccess) { fprintf(stderr, "kernel_launch: hipFuncSetAttribute failed\n"); grid = -1; return; }
        if (hipOccupancyMaxActiveBlocksPerMultiprocessor(&per_cu, (const void*)fwd_kernel, NTHR, LDS_BYTES) != hipSuccess || per_cu < 1) { fprintf(stderr, "kernel_launch: occupancy query says %d\n", per_cu); per_cu = 1; }
        (void)hipGetLastError();
        grid = cus * 1;
    }
    if (grid < 0) return;
    Params p{};
    for (int i = 0; i < 17; ++i) p.in[i] = (const float*)d_in[i];
    p.out = (float*)d_out; p.ws = (unsigned char*)d_ws;
#if MK_SPLIT
    for (int ph = 0; ph < NPHASE; ++ph) { p.ph_lo = ph; p.ph_hi = ph + 1; hipLaunchKernelGGL(fwd_kernel, dim3(grid), dim3(NTHR), LDS_BYTES, stream, p); }
#else
    p.ph_lo = 0; p.ph_hi = NPHASE;
    void* args[] = {&p};
    hipError_t e = hipLaunchCooperativeKernel((const void*)fwd_kernel, dim3(grid), dim3(NTHR), args, LDS_BYTES, stream);
    if (e != hipSuccess) fprintf(stderr, "cooperative launch failed: %s (grid %d)\n", hipGetErrorString(e), grid);
#endif
}
```

```cpp
#include <hip/hip_runtime.h>
#include <hip/hip_cooperative_groups.h>
#include <cstdio>
#include <cstdint>
namespace cg = cooperative_groups;

#ifndef MK_SPLIT
#define MK_SPLIT 0
#endif

#ifndef PROBE_DUP
#define PROBE_DUP 0
#endif
#define LAS __attribute__((address_space(3)))
typedef unsigned short bf16_t;
typedef short bf16x8 __attribute__((ext_vector_type(8)));
typedef float f32x4 __attribute__((ext_vector_type(4)));
typedef float f32x2 __attribute__((ext_vector_type(2)));
typedef unsigned u32x4 __attribute__((ext_vector_type(4)));
typedef unsigned u32x2 __attribute__((ext_vector_type(2)));

constexpr int DM = 1024, NB = 8, SEQ = 4096, CT = 256, DEPTH = 4, FF = 4096, NIN = 2048;
constexpr int ML = NB * SEQ, MC = NB * CT, MT = ML + MC;
constexpr int NMOD = 6 * DM;
constexpr int VTP = MT + 128;
constexpr int PBW = 1536;
constexpr float EPS = 1e-6f;
constexpr int NWAVES = 8, NTHR = 512;

constexpr size_t MiB = 1u << 20;
constexpr size_t WS_MOD = 0;
constexpr size_t WS_SS = 1 * MiB;
constexpr size_t WS_BAR = 3 * MiB + 512 * 1024;
constexpr size_t WS_CTXR = 4 * MiB;
constexpr size_t WS_WIN = 12 * MiB;
constexpr size_t WS_WOUT = 28 * MiB;
constexpr size_t WS_W1 = 36 * MiB;
constexpr size_t WS_W2 = 68 * MiB;
constexpr size_t WS_XN = 100 * MiB;
constexpr size_t WS_H = 168 * MiB;
constexpr size_t WS_PB = WS_H;
constexpr size_t WS_VT = 270 * MiB;
constexpr size_t WS_MIX = 306 * MiB;
constexpr size_t WS_XR = 440 * MiB;
constexpr size_t WS_END = 504 * MiB;
static_assert(WS_PB + (size_t)MT * PBW * 2 <= WS_VT && WS_VT + (size_t)512 * VTP * 2 <= WS_MIX && WS_MIX + (size_t)MT * DM * 2 <= WS_END, "ws");
static_assert(WS_H + (size_t)MT * FF * 2 <= WS_XR && WS_XR + (size_t)ML * DM * 2 <= WS_END && (size_t)8 * MC * DM * 4 <= (size_t)ML * DM * 4, "ws h");

constexpr int LDS_BYTES = 163840;

typedef __bf16 bf16v2 __attribute__((ext_vector_type(2)));
__device__ __forceinline__ unsigned cvt_pk_bf16(float lo, float hi) { const f32x2 v = (f32x2){lo, hi}; return __builtin_bit_cast(unsigned, __builtin_convertvector(v, bf16v2)); }
__device__ __forceinline__ float bf_lo(unsigned w) { return __uint_as_float(w << 16); }
__device__ __forceinline__ float bf_hi(unsigned w) { return __uint_as_float(w & 0xffff0000u); }
template <int CTRL> __device__ __forceinline__ float dpp_f(float v) { return __builtin_bit_cast(float, __builtin_amdgcn_update_dpp(0, __builtin_bit_cast(int, v), CTRL, 0xf, 0xf, false)); }
__device__ __forceinline__ float wave_sum(float v) {
    v += dpp_f<0xB1>(v); v += dpp_f<0x4E>(v); v += dpp_f<0x141>(v); v += dpp_f<0x140>(v);
    v += __shfl_xor(v, 16); v += __shfl_xor(v, 32);
    return v;
}
#define LDS_WAIT() asm volatile("s_waitcnt lgkmcnt(0)" ::: "memory")

namespace pg8 {
constexpr int BM = 256, BK = 64, HALF = 128, HTB = HALF * BK * 2, STAGE_BYTES = 8 * HTB, NXCD = 8, WGM = 8;
__host__ __device__ __forceinline__ int lds_byte(int r, int c) { const int st = (r >> 4) * 2 + (c >> 5), rr = r & 15, cc = c & 31, ob = rr * 64 + cc * 2; return st * 1024 + (ob ^ (((ob >> 9) & 1) << 5)); }
__host__ __device__ __forceinline__ void stage_rc(int b, int& R, int& C) { const int st = b / 1024, sb = b % 1024, swz = sb ^ (((sb >> 9) & 1) << 5); R = (st >> 1) * 16 + swz / 64; C = (st & 1) * 32 + (swz % 64) / 2; }
__host__ __device__ __forceinline__ int perm32(int rho) { const int n = rho >> 4, i = rho & 15; return 8 * (i >> 2) + 4 * n + (i & 3); }

struct Unit { int pm, pn, ks; };
constexpr int KSPLIT = 8;
struct Gemm { const bf16_t* A; const bf16_t* Bt; int K; int nN_main; };

struct StaticOrder {
    int nM, nN, nwg, G, c, nsplit;
    __device__ __forceinline__ void init(int nM_, int nN_, int G_, int c_, int nsplit_ = 0) { nM = nM_; nN = nN_; nwg = nM * nN; G = G_; c = c_; nsplit = nsplit_; }
    __device__ __forceinline__ bool next(int i, Unit& u) const {
        const long L = (long)i * G + c; if (L >= nwg + nsplit * nN * KSPLIT) return false;
        int pm, pn, ks;
        if (L >= nwg) { const int e = (int)L - nwg, cu = e / KSPLIT; ks = e % KSPLIT; pm = nM + cu / nN; pn = cu % nN; }
        else {
            int wgid = (int)L; { const int q = nwg / NXCD, r = nwg % NXCD, xcd = wgid % NXCD, off = wgid / NXCD; wgid = (xcd < r ? xcd * (q + 1) : r * (q + 1) + (xcd - r) * q) + off; }
            const int nig = WGM * nN, gid = wgid / nig, fm = gid * WGM, gsz = (nM - fm) < WGM ? (nM - fm) : WGM;
            pm = fm + ((wgid % nig) % gsz); pn = (wgid % nig) / gsz; ks = -1;
        }
        u.pm = pm; u.pn = pn; u.ks = ks; return true;
    }
};

template <int MODE> struct Epi {
    bf16_t* O; bf16_t* O2; float* part;
    __device__ __forceinline__ void operator()(const f32x4 (&acc)[2][2][4][2], const Unit& u, int wr, int wc, int fr, int fq) const {
        int prow = u.pm, pcol = u.pn; bf16_t* base = O; size_t ldc = (MODE == 0) ? PBW : (MODE == 1 ? DM : FF);
        if (MODE == 0 && u.pn >= 6) { prow = u.pn - 6; pcol = u.pm; base = O2; ldc = VTP; }
        const int row0 = prow * BM + wr * 64 + fr, col0 = pcol * BM + wc * 32 + 8 * fq;
        if (MODE == 1 && u.ks >= 0) {
            float* pb = part + ((size_t)u.ks * MC + (size_t)(row0 - ML)) * DM + col0;
#pragma unroll
            for (int ai = 0; ai < 2; ++ai)
#pragma unroll
                for (int m = 0; m < 4; ++m) { float* rowp = pb + (size_t)(ai * HALF + m * 16) * DM;
#pragma unroll
                    for (int bj = 0; bj < 2; ++bj) { *(f32x4*)(rowp + bj * HALF) = acc[ai][bj][m][0]; *(f32x4*)(rowp + bj * HALF + 4) = acc[ai][bj][m][1]; } }
            return;
        }
#pragma unroll
        for (int ai = 0; ai < 2; ++ai)
#pragma unroll
            for (int m = 0; m < 4; ++m) { bf16_t* rowp = base + (size_t)(row0 + ai * HALF + m * 16) * ldc + col0;
#pragma unroll
                for (int bj = 0; bj < 2; ++bj) { f32x4 v0 = acc[ai][bj][m][0], v1 = acc[ai][bj][m][1];
                    if (MODE == 2) {
#pragma unroll
                        for (int e = 0; e < 4; ++e) { const float a = fmaxf(v0[e], 0.f), b = fmaxf(v1[e], 0.f); v0[e] = a * a; v1[e] = b * b; } }
                    u32x4 w; w.x = cvt_pk_bf16(v0[0], v0[1]); w.y = cvt_pk_bf16(v0[2], v0[3]); w.z = cvt_pk_bf16(v1[0], v1[1]); w.w = cvt_pk_bf16(v1[2], v1[3]);
                    *(u32x4*)(rowp + bj * HALF) = w; } }
    }
};

template <class EpiT, bool ALIGN_EPI>
__device__ __forceinline__ void gemm_phase(LAS unsigned char* lds, const Gemm g, const StaticOrder& S, const EpiT& E, const int tid) {
    const int wid = __builtin_amdgcn_readfirstlane(tid >> 6), lane = tid & 63, wr = wid >> 2, wc = wid & 3, fr = lane & 15, fq = lane >> 4;
    const int K = g.K;
    unsigned voffA[2], voffB[2];
#pragma unroll
    for (int i = 0; i < 2; ++i) { int R, C; stage_rc(tid * 16 + i * 8192, R, C); const int Rb = (R & ~31) + perm32(R & 31);
        voffA[i] = (unsigned)(R * K + C) * 2u; voffB[i] = (unsigned)(Rb * K + C) * 2u; }
    const size_t kstep = (size_t)(BK * 2);
    const size_t hstep = (size_t)HALF * K * 2;
    const size_t tstep = 2 * hstep;
    const unsigned ldsw = (unsigned)wid * 1024u;
    const int aoff = lds_byte(wr * 64 + fr, fq * 8), boff = lds_byte(wc * 32 + fr, fq * 8);
#define PG8_SA(b, h) (((b) * 2 + (h)) * HTB)
#define PG8_SB(b, h) ((4 + (b) * 2 + (h)) * HTB)
#define PG8_STAGE(bufoff, gbase, voff) do { _Pragma("unroll") for (int _i = 0; _i < 2; ++_i) \
        __builtin_amdgcn_global_load_lds((const unsigned*)((const char*)(gbase) + (voff)[_i]), (LAS unsigned*)(lds + (bufoff) + ldsw + _i * 8192), 16, 0, 0); } while (0)
#define PG8_LDA(dst, b, h) do { _Pragma("unroll") for (int m = 0; m < 4; ++m) _Pragma("unroll") for (int k = 0; k < 2; ++k) dst[m][k] = *(const LAS bf16x8*)(lds + PG8_SA(b, h) + aoff + m * 2048 + k * 1024); } while (0)
#define PG8_LDB(dst, b, h) do { _Pragma("unroll") for (int n = 0; n < 2; ++n) _Pragma("unroll") for (int k = 0; k < 2; ++k) dst[n][k] = *(const LAS bf16x8*)(lds + PG8_SB(b, h) + boff + n * 2048 + k * 1024); } while (0)
#define PG8_MMA(ai, bj, At, Bt) do { __builtin_amdgcn_s_setprio(1); _Pragma("unroll") for (int m = 0; m < 4; ++m) _Pragma("unroll") for (int n = 0; n < 2; ++n) _Pragma("unroll") for (int k = 0; k < 2; ++k) \
        acc[ai][bj][m][n] = __builtin_amdgcn_mfma_f32_16x16x32_bf16(Bt[n][k], At[m][k], acc[ai][bj][m][n], 0, 0, 0); __builtin_amdgcn_s_setprio(0); } while (0)
#define PG8_WAIT_V(n) asm volatile("s_waitcnt vmcnt(" #n ")" ::: "memory")
#define PG8_WAIT_L(n) asm volatile("s_waitcnt lgkmcnt(" #n ")" ::: "memory")
#define PG8_BAR __builtin_amdgcn_s_barrier()
#define PG8_SCHED __builtin_amdgcn_sched_barrier(0)
#define PG8_PTRS(u, pa, pb) do { const size_t _ko = (u).ks >= 0 ? (size_t)(u).ks * (size_t)(K / KSPLIT) * 2 : 0; \
        const char* _a = (const char*)g.A + (size_t)(u).pm * tstep + _ko; const char* _b = (const char*)g.Bt + (size_t)(u).pn * tstep + _ko; \
        if ((u).pn >= g.nN_main) { pa = _b; pb = _a; } else { pa = _a; pb = _b; } } while (0)
    Unit cur, nxt; int ui = 0;
    if (!S.next(0, cur)) return;
    f32x4 acc[2][2][4][2];
#pragma unroll
    for (int a = 0; a < 2; ++a)
#pragma unroll
        for (int b = 0; b < 2; ++b)
#pragma unroll
            for (int m = 0; m < 4; ++m)
#pragma unroll
                for (int n = 0; n < 2; ++n) acc[a][b][m][n] = (f32x4){0.f, 0.f, 0.f, 0.f};
    bf16x8 At[4][2], B0[2][2], B1[2][2];
    const char* cA; const char* cB; PG8_PTRS(cur, cA, cB);
    PG8_STAGE(PG8_SB(0, 0), cB, voffB); PG8_STAGE(PG8_SB(0, 1), cB + hstep, voffB); PG8_STAGE(PG8_SA(0, 0), cA, voffA); PG8_STAGE(PG8_SA(0, 1), cA + hstep, voffA);
    if (wr == 1) PG8_BAR;
    PG8_WAIT_V(2); PG8_BAR;
    PG8_STAGE(PG8_SB(1, 0), cB + kstep, voffB); PG8_STAGE(PG8_SA(1, 0), cA + kstep, voffA); PG8_STAGE(PG8_SB(1, 1), cB + hstep + kstep, voffB);
    PG8_WAIT_V(6); PG8_BAR;
    for (;;) {
        const bool has_next = S.next(ui + 1, nxt);
        const char* nA = cA; const char* nB = cB; if (has_next) PG8_PTRS(nxt, nA, nB);
        const int nt = (cur.ks >= 0) ? (K / KSPLIT) / BK : K / BK;
        for (int t = 0; t < nt; t += 2) {
            const bool last = (t == nt - 2);
            const char* a1 = cA + (size_t)(t + 1) * kstep;
            const char* a2 = last ? nA : cA + (size_t)(t + 2) * kstep; const char* b2 = last ? nB : cB + (size_t)(t + 2) * kstep;
            const char* a3 = a2 + kstep; const char* b3 = b2 + kstep;
            PG8_LDB(B0, 0, 0); PG8_LDB(B1, 0, 1); PG8_SCHED; PG8_LDA(At, 0, 0); PG8_STAGE(PG8_SA(1, 1), a1 + hstep, voffA);
            PG8_WAIT_V(8); PG8_WAIT_L(0); PG8_BAR; PG8_MMA(0, 0, At, B0); PG8_MMA(0, 1, At, B1); PG8_BAR; PG8_SCHED;
            PG8_LDA(At, 0, 1); PG8_STAGE(PG8_SB(0, 0), b2, voffB); PG8_STAGE(PG8_SB(0, 1), b2 + hstep, voffB); PG8_STAGE(PG8_SA(0, 0), a2, voffA);
            PG8_WAIT_V(8); PG8_WAIT_L(0); PG8_BAR; PG8_MMA(1, 0, At, B0); PG8_MMA(1, 1, At, B1); PG8_BAR; PG8_SCHED;
            PG8_LDB(B0, 1, 0); PG8_LDB(B1, 1, 1); PG8_SCHED; PG8_LDA(At, 1, 0); PG8_STAGE(PG8_SA(0, 1), a2 + hstep, voffA);
            PG8_WAIT_V(8); PG8_WAIT_L(0); PG8_BAR; PG8_MMA(0, 0, At, B0); PG8_MMA(0, 1, At, B1); PG8_BAR; PG8_SCHED;
            PG8_LDA(At, 1, 1); PG8_STAGE(PG8_SB(1, 0), b3, voffB); PG8_STAGE(PG8_SB(1, 1), b3 + hstep, voffB); PG8_STAGE(PG8_SA(1, 0), a3, voffA);
            PG8_WAIT_V(8); PG8_WAIT_L(0); PG8_BAR; PG8_MMA(1, 0, At, B0); PG8_MMA(1, 1, At, B1); PG8_BAR; PG8_SCHED;
        }
        if constexpr (ALIGN_EPI) { if (wr == 0) PG8_BAR; }
        E(acc, cur, wr, wc, fr, fq);
        if (!has_next) break;
#pragma unroll
        for (int a = 0; a < 2; ++a)
#pragma unroll
            for (int b = 0; b < 2; ++b)
#pragma unroll
                for (int m = 0; m < 4; ++m)
#pragma unroll
                    for (int n = 0; n < 2; ++n) acc[a][b][m][n] = (f32x4){0.f, 0.f, 0.f, 0.f};
        cur = nxt; cA = nA; cB = nB; ++ui;
        if constexpr (ALIGN_EPI) { if (wr == 1) PG8_BAR; }
    }
    PG8_WAIT_V(0);
    if constexpr (!ALIGN_EPI) { if (wr == 0) PG8_BAR; }
    PG8_BAR;
#undef PG8_SA
#undef PG8_SB
#undef PG8_STAGE
#undef PG8_LDA
#undef PG8_LDB
#undef PG8_MMA
#undef PG8_WAIT_V
#undef PG8_WAIT_L
#undef PG8_BAR
#undef PG8_SCHED
#undef PG8_PTRS
}
}

#define XB_TMO      128
#define XB_XCNT(j)  (256  + 64 * (j))
#define XB_XSUB(j)  (1280 + 64 * (j))
#define XB_XGEN(j)  (2304 + 64 * (j))
#define XB_TOP      3328
#define XB_TOPGEN   3392
#define XCD_BAR_WORDS 3456
#define XB_SPIN_CAP (1u << 18)
__device__ __forceinline__ unsigned xb_ld(unsigned* p)              { return __hip_atomic_load(p, __ATOMIC_RELAXED, __HIP_MEMORY_SCOPE_AGENT); }
__device__ __forceinline__ unsigned xb_add(unsigned* p, unsigned v) { return __hip_atomic_fetch_add(p, v, __ATOMIC_RELAXED, __HIP_MEMORY_SCOPE_AGENT); }
__device__ __forceinline__ unsigned xb_xcc_id() { return (unsigned)__builtin_amdgcn_s_getreg((3 << 11) | 20) & 0xFu; }
#define XB_SPIN(cond, bar) do { unsigned _sp = 0; while (cond) { __builtin_amdgcn_s_sleep(1); \
    if ((++_sp & 255u) == 0u) { if (xb_ld(&(bar)[XB_TMO])) break; if (_sp > XB_SPIN_CAP) { atomicAdd(&(bar)[XB_TMO], 1u); break; } } } } while (0)
struct XcdBarrier { unsigned* bar; unsigned x; volatile LAS unsigned* st; };
__device__ __forceinline__ XcdBarrier xcd_barrier_post(unsigned* bar, volatile LAS unsigned* st) {
    XcdBarrier b; b.bar = bar; b.x = xb_xcc_id(); b.st = st;
    if (threadIdx.x == 0) (void)xb_add(&bar[XB_XCNT(b.x)], 1u);
    return b;
}
__device__ __forceinline__ void xcd_barrier_complete(unsigned* bar, unsigned x, unsigned& nloc, unsigned& nx) {
    const unsigned G = gridDim.x * gridDim.y * gridDim.z;
    unsigned sum, cnt, mine, sp = 0u;
    for (;;) {
        sum = 0u; cnt = 0u; mine = 0u;
#pragma unroll
        for (unsigned j = 0; j < 16; ++j) { const unsigned c = xb_ld(&bar[XB_XCNT(j)]); sum += c; cnt += (c > 0u) ? 1u : 0u; mine = (j == x) ? c : mine; }
        if (sum == G) break;
        __builtin_amdgcn_s_sleep(1);
        if ((++sp & 255u) == 0u) { if (xb_ld(&bar[XB_TMO])) break; if (sp > XB_SPIN_CAP) { atomicAdd(&bar[XB_TMO], 1u); break; } }
    }
    nloc = mine > 0u ? mine : 1u; nx = cnt > 0u ? cnt : 1u;
}
__device__ __forceinline__ void xcd_barrier(const XcdBarrier& b) {
    asm volatile("s_waitcnt vmcnt(0)" ::: "memory");
    __syncthreads();
    if (threadIdx.x == 0) {
        unsigned* bar = b.bar;
        __builtin_amdgcn_s_waitcnt(0);
        unsigned nloc = b.st[0], nx = b.st[1];
        if (nloc == 0u) { xcd_barrier_complete(bar, b.x, nloc, nx); b.st[0] = nloc; b.st[1] = nx; }
        const unsigned old = xb_add(&bar[XB_XSUB(b.x)], 1u);
        const unsigned gen = old / nloc;
        if (old + 1u == (gen + 1u) * nloc) {
            __builtin_amdgcn_fence(__ATOMIC_RELEASE, "agent");
            asm volatile("s_waitcnt vmcnt(0)" ::: "memory");
            const unsigned og = xb_add(&bar[XB_TOP], 1u);
            const unsigned tg = og / nx;
            if (og + 1u == (tg + 1u) * nx) xb_add(&bar[XB_TOPGEN], 1u);
            else XB_SPIN(xb_ld(&bar[XB_TOPGEN]) == tg, bar);
            __builtin_amdgcn_fence(__ATOMIC_ACQUIRE, "agent");
            xb_add(&bar[XB_XGEN(b.x)], 1u);
            asm volatile("s_waitcnt vmcnt(0)" ::: "memory");
        } else {
            XB_SPIN(xb_ld(&bar[XB_XGEN(b.x)]) == gen, bar);
            __builtin_amdgcn_fence(__ATOMIC_ACQUIRE, "agent");
            asm volatile("s_waitcnt vmcnt(0)" ::: "memory");
        }
    }
    __syncthreads();
}

struct Params {
    const float* in[17];
    float* out; unsigned char* ws;
    int ph_lo, ph_hi;
};
enum { I_X = 0, I_C, I_CTX, I_CCTX, I_WMOD, I_BMOD, I_GPREMIX, I_GPOSTMIX, I_GPREMLP, I_GPOSTMLP, I_WIN, I_POOLW, I_POOLS, I_RPB, I_WOUT, I_W1, I_W2 };

__device__ __forceinline__ void transpose_item(const float* W, int ldw, bf16_t* WT, int ldt, int kofs, int nblk, LAS float* scr, int item, int lane) {
    const int kb = item / nblk, nb = item % nblk, k0 = 64 * kb, n0 = 32 * nb;
#pragma unroll 8
    for (int i = 0; i < 32; ++i) { const int kk = 2 * i + (lane >> 5); scr[kk * 33 + (lane & 31)] = W[(size_t)(k0 + kk) * ldw + n0 + (lane & 31)]; }
    LDS_WAIT(); asm volatile("" ::: "memory");
    const int c = lane & 7;
#pragma unroll
    for (int j = 0; j < 4; ++j) { const int n = (lane >> 3) + 8 * j; const LAS float* s = scr + (8 * c) * 33 + n;
        u32x4 o; o.x = cvt_pk_bf16(s[0 * 33], s[1 * 33]); o.y = cvt_pk_bf16(s[2 * 33], s[3 * 33]); o.z = cvt_pk_bf16(s[4 * 33], s[5 * 33]); o.w = cvt_pk_bf16(s[6 * 33], s[7 * 33]);
        *(u32x4*)(WT + (size_t)(n0 + n) * ldt + kofs + k0 + 8 * c) = o; }
    LDS_WAIT(); asm volatile("" ::: "memory");
}

__device__ __forceinline__ float silu_f(float v) { return v / (1.f + __expf(-v)); }

__device__ __forceinline__ void mod_item(const Params& p, LAS unsigned char* lds, int item, int tid, int wave, int lane) {
    LAS float* sv = (LAS float*)lds;
    LAS float* part = (LAS float*)(lds + 36864);
    const int l = item / 24, j0 = (item % 24) * 256;
    for (int i = tid; i < 9 * 1024; i += NTHR) { const int r = i >> 10, k = i & 1023; const float v = (r < 8) ? p.in[I_C][r * 1024 + k] : p.in[I_CCTX][k]; sv[i] = silu_f(v); }
    __syncthreads();
    f32x4 acc[9];
#pragma unroll
    for (int r = 0; r < 9; ++r) acc[r] = (f32x4){0.f, 0.f, 0.f, 0.f};
    const float* wp = p.in[I_WMOD] + (size_t)l * DM * NMOD + (size_t)(wave * 128) * NMOD + j0 + 4 * lane;
#pragma unroll 1
    for (int k8 = 0; k8 < 128; k8 += 8) {
        f32x4 wv[8];
#pragma unroll
        for (int u = 0; u < 8; ++u) wv[u] = *(const f32x4*)(wp + (size_t)(k8 + u) * NMOD);
#pragma unroll
        for (int u = 0; u < 8; ++u)
#pragma unroll
            for (int r = 0; r < 9; ++r) { const float s = sv[r * 1024 + wave * 128 + k8 + u]; acc[r] += wv[u] * s; }
    }
#pragma unroll
    for (int r = 0; r < 9; ++r) *(LAS f32x4*)(part + (wave * 9 + r) * 256 + 4 * lane) = acc[r];
    __syncthreads();
    float* mod = (float*)(p.ws + WS_MOD) + (size_t)l * 9 * NMOD;
    for (int i = tid; i < 9 * 256; i += NTHR) { const int r = i >> 8, j = i & 255; float s = p.in[I_BMOD][l * NMOD + j0 + j];
#pragma unroll
        for (int w = 0; w < 8; ++w) s += part[(w * 9 + r) * 256 + j];
        mod[r * NMOD + j0 + j] = s; }
    __syncthreads();
}

__device__ __forceinline__ void weff_item(const Params& p, LAS unsigned char* lds, int item, int tid, int wave, int lane) {
    LAS float* pw = (LAS float*)lds;
    LAS float* wo = (LAS float*)(lds + 128 * 129 * 4);
    const int l = item >> 6, g = (item >> 4) & 3, n0 = (item & 15) * 64;
    const float* pwg = p.in[I_POOLW] + ((size_t)l * 4 + g) * 128 * 128;
    for (int i = tid; i < 128 * 128; i += NTHR) pw[(i >> 7) * 129 + (i & 127)] = pwg[i];
    const float* wog = p.in[I_WOUT] + (size_t)l * DM * DM + (size_t)(g * 128) * DM + n0;
    const float* psg = p.in[I_POOLS] + l * 512 + g * 128;
    for (int i = tid; i < 128 * 64; i += NTHR) { const int d = i >> 6, n = i & 63; wo[i] = wog[(size_t)d * DM + n] * psg[d]; }
    __syncthreads();
    float acc[16];
#pragma unroll
    for (int c = 0; c < 16; ++c) acc[c] = 0.f;
    const int n = lane, cb = wave * 16;
#pragma unroll 4
    for (int d = 0; d < 128; ++d) { const float w = wo[d * 64 + n];
#pragma unroll
        for (int c = 0; c < 16; ++c) acc[c] += pw[(cb + c) * 129 + d] * w; }
    bf16_t* dst = (bf16_t*)(p.ws + WS_WOUT) + (size_t)l * DM * DM + (size_t)(n0 + n) * DM + g * 128 + cb;
    u32x4 o0, o1;
    o0.x = cvt_pk_bf16(acc[0], acc[1]); o0.y = cvt_pk_bf16(acc[2], acc[3]); o0.z = cvt_pk_bf16(acc[4], acc[5]); o0.w = cvt_pk_bf16(acc[6], acc[7]);
    o1.x = cvt_pk_bf16(acc[8], acc[9]); o1.y = cvt_pk_bf16(acc[10], acc[11]); o1.z = cvt_pk_bf16(acc[12], acc[13]); o1.w = cvt_pk_bf16(acc[14], acc[15]);
    *(u32x4*)dst = o0; *(u32x4*)(dst + 8) = o1;
    __syncthreads();
}

__device__ __forceinline__ void phase_prologue(const Params& p, LAS unsigned char* lds, int G, int tid, int wave, int lane) {
    for (int it = blockIdx.x; it < DEPTH * 24; it += G) mod_item(p, lds, it, tid, wave, lane);
    for (int it = blockIdx.x; it < DEPTH * 64; it += G) weff_item(p, lds, it, tid, wave, lane);
    LAS float* scr = (LAS float*)(lds + wave * 16384);
    const int gw = blockIdx.x * NWAVES + wave, NGW = G * NWAVES;
    constexpr int I_IN = 16 * 64, I_O = 8 * 32, I_1 = 16 * 128, I_2 = 64 * 32, I_L = I_IN + I_O + I_1 + I_2;
    for (int it = gw; it < DEPTH * I_L; it += NGW) {
        const int l = it / I_L; int r = it % I_L;
        if (r < I_IN) { transpose_item(p.in[I_WIN] + (size_t)l * DM * NIN, NIN, (bf16_t*)(p.ws + WS_WIN) + (size_t)l * NIN * DM, DM, 0, NIN / 32, scr, r, lane); continue; } r -= I_IN;
        if (r < I_O) { transpose_item(p.in[I_WOUT] + (size_t)l * DM * DM + (size_t)512 * DM, DM, (bf16_t*)(p.ws + WS_WOUT) + (size_t)l * DM * DM, DM, 512, DM / 32, scr, r, lane); continue; } r -= I_O;
        if (r < I_1) { transpose_item(p.in[I_W1] + (size_t)l * DM * FF, FF, (bf16_t*)(p.ws + WS_W1) + (size_t)l * FF * DM, DM, 0, FF / 32, scr, r, lane); continue; } r -= I_1;
        transpose_item(p.in[I_W2] + (size_t)l * FF * DM, DM, (bf16_t*)(p.ws + WS_W2) + (size_t)l * DM * FF, FF, 0, DM / 32, scr, r, lane);
    }
}

struct RowArgs {
    const void* xlat; const void* xctx; bool xin_f32;
    void* olat; void* octx; bool xout_f32;
    const float* gpost; const float* mod_cur;
    int gate_off;
    const float* gpre; const float* mod_nxt; int sh_off, sc_off;
    int nrows; bool has_y, write_xn, ctx_split;
};
__device__ __forceinline__ f32x4 bfx4_lo(u32x4 w) { return (f32x4){bf_lo(w.x), bf_hi(w.x), bf_lo(w.y), bf_hi(w.y)}; }
__device__ __forceinline__ f32x4 bfx4_hi(u32x4 w) { return (f32x4){bf_lo(w.z), bf_hi(w.z), bf_lo(w.w), bf_hi(w.w)}; }
__device__ __forceinline__ void phase_rows(const Params& p, const RowArgs& a, int G, int wave, int lane) {
    bf16_t* XN = (bf16_t*)(p.ws + WS_XN);
    const int gw = blockIdx.x * NWAVES + wave, NGW = G * NWAVES;
    f32x4 gpo[4], gpr[4];
#pragma unroll
    for (int j = 0; j < 4; ++j) { const int c = 8 * lane + 512 * (j >> 1) + 4 * (j & 1);
        gpo[j] = a.has_y ? *(const f32x4*)(a.gpost + c) : (f32x4){0.f, 0.f, 0.f, 0.f};
        gpr[j] = a.write_xn ? *(const f32x4*)(a.gpre + c) : (f32x4){0.f, 0.f, 0.f, 0.f}; }
    const int wpb = NGW / NB;
    const bool bmaj = (NGW % NB == 0) && ((SEQ / 2) % wpb == 0);
    const int ppw = bmaj ? (SEQ / 2) / wpb : 0;
    const int nit = bmaj ? ppw + ((a.nrows > ML) ? ((a.nrows - ML) / 2 + NGW - 1) / NGW : 0) : (a.nrows / 2 + NGW - 1) / NGW;
    int cur_rb = -1;
    f32x4 gt[4], sh[4], sc[4];
#pragma unroll 1
    for (int it = 0; it < nit; ++it) {
        int mp;
        if (bmaj) mp = (it < ppw) ? (gw / wpb) * (SEQ / 2) + (gw % wpb) + it * wpb : ML / 2 + gw + (it - ppw) * NGW;
        else mp = gw + it * NGW;
        if (mp >= a.nrows / 2) break;
        const int m0 = 2 * mp; const bool isl = m0 < ML; const int rb = isl ? (m0 >> 12) : 8;
        const size_t xoff = isl ? (size_t)m0 * DM : (size_t)(m0 - ML) * DM;
        const void* xrb = isl ? a.xlat : a.xctx; void* xob = isl ? a.olat : a.octx;
        bf16_t* xn = XN + (size_t)m0 * DM;
        const size_t moff = (size_t)rb * NMOD;
        f32x4 v[2][4], y[2][4];
        if (a.xin_f32) {
#pragma unroll
            for (int u = 0; u < 2; ++u)
#pragma unroll
                for (int j = 0; j < 4; ++j) v[u][j] = *(const f32x4*)((const float*)xrb + xoff + u * DM + 8 * lane + 512 * (j >> 1) + 4 * (j & 1));
        } else {
#pragma unroll
            for (int u = 0; u < 2; ++u)
#pragma unroll
                for (int jb = 0; jb < 2; ++jb) { const u32x4 xw = *(const u32x4*)((const bf16_t*)xrb + xoff + u * DM + 8 * lane + 512 * jb); v[u][2 * jb] = bfx4_lo(xw); v[u][2 * jb + 1] = bfx4_hi(xw); }
        }
        if (a.has_y) {
            if (isl || !a.ctx_split) {
#pragma unroll
                for (int u = 0; u < 2; ++u)
#pragma unroll
                    for (int jb = 0; jb < 2; ++jb) { const u32x4 yw = *(const u32x4*)(xn + u * DM + 8 * lane + 512 * jb); y[u][2 * jb] = bfx4_lo(yw); y[u][2 * jb + 1] = bfx4_hi(yw); }
            } else {
                const float* part = (const float*)p.out;
#pragma unroll
                for (int u = 0; u < 2; ++u)
#pragma unroll
                    for (int j = 0; j < 4; ++j) { const float* pp = part + (size_t)(m0 + u - ML) * DM + 8 * lane + 512 * (j >> 1) + 4 * (j & 1); f32x4 s = *(const f32x4*)pp;
#pragma unroll
                        for (int k = 1; k < pg8::KSPLIT; ++k) s += *(const f32x4*)(pp + (size_t)k * MC * DM);
                        y[u][j] = s; }
            }
        }
        if (rb != cur_rb) {
            cur_rb = rb;
            if (a.has_y) {
#pragma unroll
                for (int j = 0; j < 4; ++j) gt[j] = *(const f32x4*)(a.mod_cur + moff + a.gate_off + 8 * lane + 512 * (j >> 1) + 4 * (j & 1));
            }
            if (a.write_xn) {
#pragma unroll
                for (int j = 0; j < 4; ++j) { const int c = 8 * lane + 512 * (j >> 1) + 4 * (j & 1); sh[j] = *(const f32x4*)(a.mod_nxt + moff + a.sh_off + c); sc[j] = *(const f32x4*)(a.mod_nxt + moff + a.sc_off + c); }
            }
        }
        __builtin_amdgcn_sched_barrier(0);
        if (a.has_y) {
#pragma unroll
            for (int u = 0; u < 2; ++u) {
                float s = 0.f;
#pragma unroll
                for (int j = 0; j < 4; ++j) s += (y[u][j][0] * y[u][j][0] + y[u][j][1] * y[u][j][1]) + (y[u][j][2] * y[u][j][2] + y[u][j][3] * y[u][j][3]);
                const float rstd = rsqrtf(wave_sum(s) * (1.f / DM) + EPS);
#pragma unroll
                for (int j = 0; j < 4; ++j) v[u][j] = v[u][j] + gt[j] * (y[u][j] * rstd * gpo[j]);
                if (a.xout_f32) {
#pragma unroll
                    for (int j = 0; j < 4; ++j) *(f32x4*)((float*)xob + xoff + u * DM + 8 * lane + 512 * (j >> 1) + 4 * (j & 1)) = v[u][j];
                } else {
#pragma unroll
                    for (int jb = 0; jb < 2; ++jb) { u32x4 w; w.x = cvt_pk_bf16(v[u][2 * jb][0], v[u][2 * jb][1]); w.y = cvt_pk_bf16(v[u][2 * jb][2], v[u][2 * jb][3]);
                        w.z = cvt_pk_bf16(v[u][2 * jb + 1][0], v[u][2 * jb + 1][1]); w.w = cvt_pk_bf16(v[u][2 * jb + 1][2], v[u][2 * jb + 1][3]);
                        *(u32x4*)((bf16_t*)xob + xoff + u * DM + 8 * lane + 512 * jb) = w; v[u][2 * jb] = bfx4_lo(w); v[u][2 * jb + 1] = bfx4_hi(w); }
                } }
        }
        if (a.write_xn) {
#pragma unroll
            for (int u = 0; u < 2; ++u) {
                float s2 = 0.f;
#pragma unroll
                for (int j = 0; j < 4; ++j) s2 += (v[u][j][0] * v[u][j][0] + v[u][j][1] * v[u][j][1]) + (v[u][j][2] * v[u][j][2] + v[u][j][3] * v[u][j][3]);
                const float rstd = rsqrtf(wave_sum(s2) * (1.f / DM) + EPS);
#pragma unroll
                for (int jb = 0; jb < 2; ++jb) { const f32x4 h0 = (v[u][2 * jb] * rstd * gpr[2 * jb]) * (sc[2 * jb] + 1.f) + sh[2 * jb], h1 = (v[u][2 * jb + 1] * rstd * gpr[2 * jb + 1]) * (sc[2 * jb + 1] + 1.f) + sh[2 * jb + 1];
                    u32x4 w; w.x = cvt_pk_bf16(h0[0], h0[1]); w.y = cvt_pk_bf16(h0[2], h0[3]); w.z = cvt_pk_bf16(h1[0], h1[1]); w.w = cvt_pk_bf16(h1[2], h1[3]);
                    *(u32x4*)(xn + u * DM + 8 * lane + 512 * jb) = w; } }
        }
    }
}

constexpr float LOG2E = 1.4426950408889634f;
constexpr int RPB_PITCH = 64, RPB_OFF = 16;

constexpr int AT_KC = 0, AT_VC = 32768;
constexpr int AT_KL = 0, AT_VL = 73728, AT_VLP = 1280, AT_RPB = AT_VL + 64 * AT_VLP;
static_assert(AT_RPB + 15 * 64 * 4 <= LDS_BYTES - 16, "attention LDS map");
__device__ __forceinline__ int kswz(int key) { return ((key >> 1) & 1) | (((key >> 3) & 3) << 1); }

template <bool LOC>
__device__ __forceinline__ void attn_half(const LAS unsigned char* lds, int kaddr0, int kaddr1, int kcs, int vrow, int vchunk0, int vcs, int vpitch_dt,
                                          const LAS float* bp, int elo, const bf16x8 q0, const bf16x8 q1, float& mx, float& lsum, f32x4 (&o)[4], int g, int qi) {
    constexpr float SC = 0.125f * LOG2E;
    float s[8][8];
    bf16x8 kf[2][4];
#define AH_LDK(c, bufi) do { kf[bufi][0] = *(const LAS bf16x8*)(lds + kaddr0 + (c) * kcs); kf[bufi][1] = *(const LAS bf16x8*)(lds + kaddr1 + (c) * kcs); \
        kf[bufi][2] = *(const LAS bf16x8*)(lds + kaddr0 + (c) * kcs + 512); kf[bufi][3] = *(const LAS bf16x8*)(lds + kaddr1 + (c) * kcs + 512); } while (0)
    AH_LDK(0, 0);
#pragma unroll
    for (int c = 0; c < 8; ++c) {
        if (c < 7) AH_LDK(c + 1, (c + 1) & 1);
        __builtin_amdgcn_sched_barrier(0);
        f32x4 t0 = (f32x4){0.f, 0.f, 0.f, 0.f}, t1 = (f32x4){0.f, 0.f, 0.f, 0.f};
        t0 = __builtin_amdgcn_mfma_f32_16x16x32_bf16(kf[c & 1][0], q0, t0, 0, 0, 0); t1 = __builtin_amdgcn_mfma_f32_16x16x32_bf16(kf[c & 1][2], q0, t1, 0, 0, 0);
        t0 = __builtin_amdgcn_mfma_f32_16x16x32_bf16(kf[c & 1][1], q1, t0, 0, 0, 0); t1 = __builtin_amdgcn_mfma_f32_16x16x32_bf16(kf[c & 1][3], q1, t1, 0, 0, 0);
#pragma unroll
        for (int e = 0; e < 8; ++e) { const float a = (e < 4) ? t0[e] : t1[e - 4];
            if (LOC) { const float bv = bp[c * RPB_PITCH + e]; const bool ok = (e >= elo) && (e < elo + 16); s[c][e] = ok ? (a * SC + bv) : -INFINITY; }
            else s[c][e] = a * SC; }
        __builtin_amdgcn_sched_barrier(0);
    }
#undef AH_LDK
    float m2 = mx;
#pragma unroll
    for (int c = 0; c < 8; ++c)
#pragma unroll
        for (int e = 0; e < 8; ++e) m2 = fmaxf(m2, s[c][e]);
    m2 = fmaxf(m2, __shfl_xor(m2, 16)); m2 = fmaxf(m2, __shfl_xor(m2, 32));
    const float alpha = __builtin_amdgcn_exp2f(mx - m2);
    mx = m2; lsum *= alpha;
#pragma unroll
    for (int dt = 0; dt < 4; ++dt) o[dt] = o[dt] * alpha;
    bf16x8 vf[2][4];
#define AH_LDV(c, bufi) do { const int vaddr = vrow + (((vchunk0 + (c) * vcs + g) ^ qi) << 4); _Pragma("unroll") for (int dt = 0; dt < 4; ++dt) vf[bufi][dt] = *(const LAS bf16x8*)(lds + vaddr + dt * vpitch_dt); } while (0)
    AH_LDV(0, 0);
#pragma unroll
    for (int c = 0; c < 8; ++c) {
        if (c < 7) AH_LDV(c + 1, (c + 1) & 1);
        __builtin_amdgcn_sched_barrier(0);
        float pe[8];
#pragma unroll
        for (int e = 0; e < 8; ++e) { pe[e] = __builtin_amdgcn_exp2f(s[c][e] - mx); lsum += pe[e]; }
        u32x4 pw; pw.x = cvt_pk_bf16(pe[0], pe[1]); pw.y = cvt_pk_bf16(pe[2], pe[3]); pw.z = cvt_pk_bf16(pe[4], pe[5]); pw.w = cvt_pk_bf16(pe[6], pe[7]);
        const bf16x8 pb = __builtin_bit_cast(bf16x8, pw);
#pragma unroll
        for (int dt = 0; dt < 4; ++dt) o[dt] = __builtin_amdgcn_mfma_f32_16x16x32_bf16(vf[c & 1][dt], pb, o[dt], 0, 0, 0);
        __builtin_amdgcn_sched_barrier(0);
    }
#undef AH_LDV
}

__device__ __forceinline__ void attn_store(bf16_t* MIX, int qtok, int h, int g, float lsum, const f32x4 (&o)[4]) {
    lsum += __shfl_xor(lsum, 16); lsum += __shfl_xor(lsum, 32);
    const float inv = 1.f / lsum;
    bf16_t* op = MIX + (size_t)qtok * DM + 512 + h * 64 + 4 * g;
#pragma unroll
    for (int dt = 0; dt < 4; ++dt) { u32x2 w; w.x = cvt_pk_bf16(o[dt][0] * inv, o[dt][1] * inv); w.y = cvt_pk_bf16(o[dt][2] * inv, o[dt][3] * inv); *(u32x2*)(op + 16 * dt) = w; }
}

__device__ __forceinline__ void phase_mixer(const Params& p, LAS unsigned char* lds, int l, bool with_ctx, int G, int tid, int wave, int lane, int rep_attn, int rep_pool) {
    const bf16_t* PB = (const bf16_t*)(p.ws + WS_PB); const bf16_t* VT = (const bf16_t*)(p.ws + WS_VT); bf16_t* MIX = (bf16_t*)(p.ws + WS_MIX);
    const int gw = blockIdx.x * NWAVES + wave, NGW = G * NWAVES;
    const int qi = lane & 15, g = lane >> 4, kap = 8 * (qi >> 2) + (qi & 3);
#pragma unroll 1
    for (int ra = 0; ra < rep_attn; ++ra)
#pragma unroll 1
    for (int I = blockIdx.x; I < 64 * 32; I += G) {
        const int x = I & 7, t = I >> 3, j = t & 31, rho = t >> 5, pr = rho * 8 + x, b = pr >> 3, h = pr & 7;
        const int r0 = 2 * j, rs0 = min(max(r0 - 4, 0), 56);
        const int r = r0 + (wave >> 2), n = wave & 3, rs = min(max(r - 4, 0), 56), kc0 = min(max(16 * n - 8, 0), 32);
        const int qc = 16 * n + qi, qs = min(max(qc - 8, 0), 48);
        const int sel = (j - 2 * rho) & 31;
        const int npass = (with_ctx && sel < 2) ? 2 : 1;
        {
            u32x4 kreg[4], vreg[4];
            const bf16_t* ksrc = PB + (size_t)(ML + b * CT + (tid >> 3)) * PBW + 1024 + h * 64 + (tid & 7) * 8;
            const bf16_t* vsrc = VT + (size_t)(h * 64 + (tid >> 5)) * VTP + ML + b * CT + (tid & 31) * 8;
#pragma unroll
            for (int ps = 0; ps < 4; ++ps) { kreg[ps] = *(const u32x4*)(ksrc + (size_t)(ps * 64) * PBW); vreg[ps] = *(const u32x4*)(vsrc + (size_t)(ps * 16) * VTP); }
            __builtin_amdgcn_sched_barrier(0);
#pragma unroll
            for (int ps = 0; ps < 4; ++ps) { const int key = ps * 64 + (tid >> 3), d = ps * 16 + (tid >> 5);
                *(LAS u32x4*)(lds + AT_KC + key * 128 + ((((tid & 7) ^ kswz(key))) << 4)) = kreg[ps];
                *(LAS u32x4*)(lds + AT_VC + d * 512 + ((((tid & 31) ^ (d & 15))) << 4)) = vreg[ps]; }
        }
        __syncthreads();
        float mxA = -INFINITY, lA = 0.f; f32x4 oA[4]; bf16x8 qA0, qA1;
        {
            const int kl = kap, ka0 = AT_KC + kl * 128 + ((g ^ kswz(kl)) << 4), ka1 = AT_KC + kl * 128 + (((g + 4) ^ kswz(kl)) << 4);
            const int vrow = AT_VC + qi * 512;
#pragma unroll 1
            for (int ps = 2 - npass; ps < 2; ++ps) {
                const int qtok = (ps == 1) ? (b * SEQ + r * 64 + 16 * n + qi) : (ML + b * CT + 16 * (sel * 8 + wave) + qi);
                const bf16_t* qp = PB + (size_t)qtok * PBW + 512 + h * 64 + 8 * g;
                qA0 = *(const bf16x8*)qp; qA1 = *(const bf16x8*)(qp + 32);
                mxA = -INFINITY; lA = 0.f;
#pragma unroll
                for (int dt = 0; dt < 4; ++dt) oA[dt] = (f32x4){0.f, 0.f, 0.f, 0.f};
                attn_half<false>(lds, ka0, ka1, 32 * 128, vrow, 0, 4, 16 * 512, nullptr, 0, qA0, qA1, mxA, lA, oA, g, qi);
                if (ps == 0) attn_store(MIX, qtok, h, g, lA, oA);
            }
        }
        __syncthreads();
        {
            const int tok0 = b * SEQ + rs0 * 64;
            const bf16_t* ksrc = PB + (size_t)(tok0 + (tid >> 3)) * PBW + 1024 + h * 64 + (tid & 7) * 8;
            u32x4 kreg[9], vreg[9];
#pragma unroll
            for (int ps = 0; ps < 9; ++ps) { const int idx = ps * 512 + tid, d = idx / 72, ch = idx - d * 72;
                kreg[ps] = *(const u32x4*)(ksrc + (size_t)(ps * 64) * PBW);
                vreg[ps] = *(const u32x4*)(VT + (size_t)(h * 64 + d) * VTP + tok0 + ch * 8); }
            __builtin_amdgcn_sched_barrier(0);
#pragma unroll
            for (int ps = 0; ps < 9; ++ps) { const int key = ps * 64 + (tid >> 3), idx = ps * 512 + tid, d = idx / 72, ch = idx - d * 72;
                *(LAS u32x4*)(lds + AT_KL + key * 128 + ((((tid & 7) ^ kswz(key))) << 4)) = kreg[ps];
                *(LAS u32x4*)(lds + AT_VL + d * AT_VLP + ((ch ^ (d & 15)) << 4)) = vreg[ps]; }
            LAS float* rp = (LAS float*)(lds + AT_RPB);
            for (int i = tid; i < 15 * RPB_PITCH; i += NTHR) { const int row = i >> 6, cc = (i & 63) - RPB_OFF; rp[i] = (cc >= 0 && cc < 31) ? p.in[I_RPB][(size_t)(l * 8 + h) * 15 * 31 + row * 31 + cc] * LOG2E : 0.f; }
        }
        __syncthreads();
        {
            const int kl = (rs - rs0) * 64 + kc0 + kap, ka0 = AT_KL + kl * 128 + ((g ^ kswz(kl)) << 4), ka1 = AT_KL + kl * 128 + (((g + 4) ^ kswz(kl)) << 4);
            const int vrow = AT_VL + qi * AT_VLP, vch0 = (rs - rs0) * 8 + (kc0 >> 3);
            const LAS float* bp = (const LAS float*)(lds + AT_RPB) + (rs - r + 7) * RPB_PITCH + RPB_OFF + (kc0 + 8 * g - qc + 15);
            attn_half<true>(lds, ka0, ka1, 64 * 128, vrow, vch0, 8, 16 * AT_VLP, bp, qs - kc0 - 8 * g, qA0, qA1, mxA, lA, oA, g, qi);
            attn_store(MIX, b * SEQ + r * 64 + 16 * n + qi, h, g, lA, oA);
        }
        __syncthreads();
    }
    const int nrun = (with_ctx ? MT : ML) / 16;
    const int grp = lane >> 4, lo = 1 << grp, hi = lo - 1;
#pragma unroll 1
    for (int rp = 0; rp < rep_pool; ++rp)
#pragma unroll 1
    for (int run = gw; run < nrun; run += NGW) {
        const int tok0 = run * 16; const bool isl = tok0 < ML;
        const int base = isl ? (tok0 & ~(SEQ - 1)) : (ML + ((tok0 - ML) & ~(CT - 1))), len = isl ? SEQ : CT, t0 = tok0 - base;
        u32x4 w[31];
#pragma unroll
        for (int i = 0; i < 31; ++i) { const int tt = min(max(t0 - 8 + i, 0), len - 1); w[i] = *(const u32x4*)(PB + (size_t)(base + tt) * PBW + 8 * lane); }
#pragma unroll
        for (int o = 0; o < 16; ++o) {
            const int t = t0 + o, st = max(t - lo, 0), en = min(t + hi + 1, len);
            float acc[8];
#pragma unroll
            for (int e = 0; e < 8; ++e) acc[e] = 0.f;
#pragma unroll
            for (int i = 0; i < 16; ++i) { const int tt = t + i - 8; const float wt = (tt >= st && tt < en) ? 1.f : 0.f; const u32x4 ww = w[o + i];
                acc[0] += wt * bf_lo(ww.x); acc[1] += wt * bf_hi(ww.x); acc[2] += wt * bf_lo(ww.y); acc[3] += wt * bf_hi(ww.y);
                acc[4] += wt * bf_lo(ww.z); acc[5] += wt * bf_hi(ww.z); acc[6] += wt * bf_lo(ww.w); acc[7] += wt * bf_hi(ww.w); }
            const float ic = 1.f / (float)(en - st);
            const u32x4 sw = w[o + 8];
            u32x4 ov; ov.x = cvt_pk_bf16(acc[0] * ic - bf_lo(sw.x), acc[1] * ic - bf_hi(sw.x)); ov.y = cvt_pk_bf16(acc[2] * ic - bf_lo(sw.y), acc[3] * ic - bf_hi(sw.y));
            ov.z = cvt_pk_bf16(acc[4] * ic - bf_lo(sw.z), acc[5] * ic - bf_hi(sw.z)); ov.w = cvt_pk_bf16(acc[6] * ic - bf_lo(sw.w), acc[7] * ic - bf_hi(sw.w));
            *(u32x4*)(MIX + (size_t)(tok0 + o) * DM + 8 * lane) = ov;
        }
    }
    __syncthreads();
}

constexpr int NPHASE = 2 + 7 * DEPTH;
__global__ void __launch_bounds__(NTHR) fwd_kernel(Params p) {
    extern __shared__ __attribute__((aligned(16))) unsigned char lds_raw[];
    LAS unsigned char* lds = (LAS unsigned char*)lds_raw;
    const int G = gridDim.x;
    const int ph_hi = p.ph_hi;
    volatile LAS unsigned* xst = (volatile LAS unsigned*)(lds + LDS_BYTES - 16);
    if (threadIdx.x < 4) xst[threadIdx.x] = 0u;
    unsigned* const xbar = (unsigned*)(p.ws + WS_BAR);
    if (blockIdx.x == 0) for (int i = threadIdx.x; i < XCD_BAR_WORDS; i += NTHR) __hip_atomic_store(&xbar[i], 0u, __ATOMIC_RELAXED, __HIP_MEMORY_SCOPE_AGENT);
    __syncthreads();
    XcdBarrier xb; xb.bar = xbar; xb.x = 0; xb.st = xst;
    bool xb_posted = false;
    for (int ph = p.ph_lo; ph < ph_hi; ++ph) {
#if PROBE_DUP
        int ptype = -1; if (ph == 0) ptype = 0; else if (ph >= 2) { const int s_ = (ph - 2) % 7; ptype = (s_ == 0) ? 2 : (s_ == 1) ? 1 : (s_ == 2) ? 3 : (s_ == 4) ? 4 : (s_ == 5) ? 5 : -1; }
        const int nrep = (ptype >= 0 && ((PROBE_DUP >> ptype) & 1)) ? 2 : 1;
        for (int rep = 0; rep < nrep; ++rep) {
        if (rep) __syncthreads();
#endif
        int z = 0; asm volatile("s_mov_b32 %0, 0" : "=s"(z));
        Params q;
#pragma unroll
        for (int i = 0; i < 17; ++i) q.in[i] = p.in[i] + z;
        q.out = p.out + z; q.ws = p.ws + z; q.ph_lo = 0; q.ph_hi = 0;
        const int tid = threadIdx.x + z, lane = tid & 63, wave = __builtin_amdgcn_readfirstlane(tid >> 6);
        const float* mod = (const float*)(q.ws + WS_MOD);
        bf16_t* XN = (bf16_t*)(q.ws + WS_XN);
        bf16_t* ctxr = (bf16_t*)(q.ws + WS_CTXR); bf16_t* xres = (bf16_t*)(q.ws + WS_XR);
        if (ph == 0) phase_prologue(q, lds, G, tid, wave, lane);
        else if (ph == 1) {
            RowArgs a{}; a.xlat = q.in[I_X]; a.xctx = q.in[I_CTX]; a.xin_f32 = true; a.nrows = MT; a.has_y = false; a.write_xn = true;
            a.gpre = q.in[I_GPREMIX]; a.mod_nxt = mod; a.sh_off = 0; a.sc_off = DM;
            phase_rows(q, a, G, wave, lane);
        } else {
            const int l = (ph - 2) / 7, s = (ph - 2) % 7; const bool last = (l == DEPTH - 1);
            const int nMrows = last ? ML / 256 : MT / 256;
            if (s == 0) {
                pg8::Gemm g{XN, (const bf16_t*)(q.ws + WS_WIN) + (size_t)l * NIN * DM, DM, 6};
                pg8::StaticOrder S; S.init(MT / 256, 8, G, (int)blockIdx.x);
                pg8::Epi<0> E{(bf16_t*)(q.ws + WS_PB), (bf16_t*)(q.ws + WS_VT), nullptr};
                pg8::gemm_phase<pg8::Epi<0>, true>(lds, g, S, E, tid);
            } else if (s == 1) {
                phase_mixer(q, lds, l, !last, G, tid, wave, lane, 1 + ((PROBE_DUP >> 8) & 1), 1 + ((PROBE_DUP >> 6) & 1));
            } else if (s == 2) {
                pg8::Gemm g{(const bf16_t*)(q.ws + WS_MIX), (const bf16_t*)(q.ws + WS_WOUT) + (size_t)l * DM * DM, DM, 1 << 30};
                pg8::StaticOrder S; S.init(ML / 256, 4, G, (int)blockIdx.x, last ? 0 : MC / 256);
                pg8::Epi<1> E{XN, nullptr, q.out};
                pg8::gemm_phase<pg8::Epi<1>, true>(lds, g, S, E, tid);
            } else if (s == 3) {
                RowArgs a{}; a.xlat = (l == 0) ? (const void*)q.in[I_X] : (const void*)xres; a.xctx = (l == 0) ? (const void*)q.in[I_CTX] : (const void*)ctxr; a.xin_f32 = (l == 0); a.olat = xres; a.octx = ctxr; a.xout_f32 = false;
                a.gpost = q.in[I_GPOSTMIX] + l * DM; a.mod_cur = mod + (size_t)l * 9 * NMOD; a.gate_off = 2 * DM;
                a.gpre = q.in[I_GPREMLP] + l * DM; a.mod_nxt = a.mod_cur; a.sh_off = 3 * DM; a.sc_off = 4 * DM;
                a.nrows = nMrows * 256; a.has_y = true; a.write_xn = true; a.ctx_split = true;
                phase_rows(q, a, G, wave, lane);
            } else if (s == 4) {
                pg8::Gemm g{XN, (const bf16_t*)(q.ws + WS_W1) + (size_t)l * FF * DM, DM, 1 << 30};
                pg8::StaticOrder S; S.init(nMrows, 16, G, (int)blockIdx.x);
                pg8::Epi<2> E{(bf16_t*)(q.ws + WS_H), nullptr, nullptr};
                pg8::gemm_phase<pg8::Epi<2>, true>(lds, g, S, E, tid);
            } else if (s == 5) {
                pg8::Gemm g{(const bf16_t*)(q.ws + WS_H), (const bf16_t*)(q.ws + WS_W2) + (size_t)l * DM * FF, FF, 1 << 30};
                pg8::StaticOrder S; S.init(ML / 256, 4, G, (int)blockIdx.x, last ? 0 : MC / 256);
                pg8::Epi<1> E{XN, nullptr, q.out};
                pg8::gemm_phase<pg8::Epi<1>, true>(lds, g, S, E, tid);
            } else {
                RowArgs a{}; a.xlat = xres; a.xctx = ctxr; a.xin_f32 = false; a.olat = last ? (void*)q.out : (void*)xres; a.octx = ctxr; a.xout_f32 = last;
                a.gpost = q.in[I_GPOSTMLP] + l * DM; a.mod_cur = mod + (size_t)l * 9 * NMOD; a.gate_off = 5 * DM;
                a.nrows = nMrows * 256; a.has_y = true; a.write_xn = !last; a.ctx_split = true;
                if (!last) { a.gpre = q.in[I_GPREMIX] + (l + 1) * DM; a.mod_nxt = mod + (size_t)(l + 1) * 9 * NMOD; a.sh_off = 0; a.sc_off = DM; }
                phase_rows(q, a, G, wave, lane);
            }
        }
#if PROBE_DUP
        }
#endif
        if (ph + 1 < ph_hi) {
            if (!xb_posted) { cg::this_grid().sync(); xb = xcd_barrier_post(xbar, xst); xb_posted = true; }
            else { xcd_barrier(xb); if (PROBE_DUP & 128) xcd_barrier(xb); }
        }
    }
}

extern "C" void kernel_launch(void* const* d_in, const int* in_sizes, int n_in, void* d_out, int out_size, void* d_ws, size_t ws_size, hipStream_t stream) {
    static int grid = 0;
    if (grid == 0) {
        if (n_in != 17 || in_sizes[0] != ML * DM || out_size != ML * DM || ws_size < WS_END) { fprintf(stderr, "kernel_launch: unexpected shapes (n_in %d, in0 %d, out %d, ws %zu)\n", n_in, n_in > 0 ? in_sizes[0] : -1, out_size, ws_size); grid = -1; return; }
        int dev = 0, cus = 0, per_cu = 0;
        (void)hipGetDevice(&dev);
        (void)hipDeviceGetAttribute(&cus, hipDeviceAttributeMultiprocessorCount, dev);
        if (hipFuncSetAttribute((const void*)fwd_kernel, hipFuncAttributeMaxDynamicSharedMemorySize, LDS_BYTES) != hipSuccess) { fprintf(stderr, "kernel_launch: hipFuncSetAttribute failed\n"); grid = -1; return; }
        if (hipOccupancyMaxActiveBlocksPerMultiprocessor(&per_cu, (const void*)fwd_kernel, NTHR, LDS_BYTES) != hipSuccess || per_cu < 1) { fprintf(stderr, "kernel_launch: occupancy query says %d\n", per_cu); per_cu = 1; }
        (void)hipGetLastError();
        grid = cus * 1;
    }
    if (grid < 0) return;
    Params p{};
    for (int i = 0; i < 17; ++i) p.in[i] = (const float*)d_in[i];
    p.out = (float*)d_out; p.ws = (unsigned char*)d_ws;
#if MK_SPLIT
    for (int ph = 0; ph < NPHASE; ++ph) { p.ph_lo = ph; p.ph_hi = ph + 1; hipLaunchKernelGGL(fwd_kernel, dim3(grid), dim3(NTHR), LDS_BYTES, stream, p); }
#else
    p.ph_lo = 0; p.ph_hi = NPHASE;
    void* args[] = {&p};
    hipError_t e = hipLaunchCooperativeKernel((const void*)fwd_kernel, dim3(grid), dim3(NTHR), args, LDS_BYTES, stream);
    if (e != hipSuccess) fprintf(stderr, "cooperative launch failed: %s (grid %d)\n", hipGetErrorString(e), grid);
#endif
}
```

```cpp
#include <hip/hip_runtime.h>
#include <hip/hip_cooperative_groups.h>
#include <cstdio>
#include <cstdint>
namespace cg = cooperative_groups;

#ifndef MK_SPLIT
#define MK_SPLIT 0
#endif

#ifndef PROBE_DUP
#define PROBE_DUP 0
#endif
#define LAS __attribute__((address_space(3)))
typedef unsigned short bf16_t;
typedef short bf16x8 __attribute__((ext_vector_type(8)));
typedef float f32x4 __attribute__((ext_vector_type(4)));
typedef float f32x2 __attribute__((ext_vector_type(2)));
typedef unsigned u32x4 __attribute__((ext_vector_type(4)));
typedef unsigned u32x2 __attribute__((ext_vector_type(2)));

constexpr int DM = 1024, NB = 8, SEQ = 4096, CT = 256, DEPTH = 4, FF = 4096, NIN = 2048;
constexpr int ML = NB * SEQ, MC = NB * CT, MT = ML + MC;
constexpr int NMOD = 6 * DM;
constexpr int VTP = MT + 128;
constexpr int PBW = 1536;
constexpr float EPS = 1e-6f;
constexpr int NWAVES = 8, NTHR = 512;

constexpr size_t MiB = 1u << 20;
constexpr size_t WS_MOD = 0;
constexpr size_t WS_CNT = 1 * MiB;
constexpr size_t WS_SLOT1 = 1 * MiB + 512 * 1024, WS_SLOT2 = 2 * MiB;
constexpr int CNT_BANK = 128 * 64;
constexpr size_t WS_BAR = 3 * MiB + 512 * 1024;
constexpr size_t WS_CTXR = 4 * MiB;
constexpr size_t WS_WIN = 12 * MiB;
constexpr size_t WS_WOUT = 28 * MiB;
constexpr size_t WS_W1 = 36 * MiB;
constexpr size_t WS_W2 = 68 * MiB;
constexpr size_t WS_XN = 100 * MiB;
constexpr size_t WS_H = 168 * MiB;
constexpr size_t WS_PB = WS_H;
constexpr size_t WS_VT = 270 * MiB;
constexpr size_t WS_MIX = 306 * MiB;
constexpr size_t WS_XR = 440 * MiB;
constexpr size_t WS_END = 504 * MiB;
static_assert(WS_PB + (size_t)MT * PBW * 2 <= WS_VT && WS_VT + (size_t)512 * VTP * 2 <= WS_MIX && WS_MIX + (size_t)MT * DM * 2 <= WS_END, "ws");
static_assert(WS_H + (size_t)MT * FF * 2 <= WS_XR && WS_XR + (size_t)ML * DM * 2 <= WS_END && (size_t)8 * MC * DM * 4 <= (size_t)ML * DM * 4, "ws h");

constexpr int LDS_BYTES = 163840;

typedef __bf16 bf16v2 __attribute__((ext_vector_type(2)));
__device__ __forceinline__ unsigned cvt_pk_bf16(float lo, float hi) { const f32x2 v = (f32x2){lo, hi}; return __builtin_bit_cast(unsigned, __builtin_convertvector(v, bf16v2)); }
__device__ __forceinline__ float bf_lo(unsigned w) { return __uint_as_float(w << 16); }
__device__ __forceinline__ float bf_hi(unsigned w) { return __uint_as_float(w & 0xffff0000u); }
template <int CTRL> __device__ __forceinline__ float dpp_f(float v) { return __builtin_bit_cast(float, __builtin_amdgcn_update_dpp(0, __builtin_bit_cast(int, v), CTRL, 0xf, 0xf, false)); }
__device__ __forceinline__ float wave_sum(float v) {
    v += dpp_f<0xB1>(v); v += dpp_f<0x4E>(v); v += dpp_f<0x141>(v); v += dpp_f<0x140>(v);
    v += __shfl_xor(v, 16); v += __shfl_xor(v, 32);
    return v;
}
#define LDS_WAIT() asm volatile("s_waitcnt lgkmcnt(0)" ::: "memory")
__device__ __forceinline__ f32x4 bfx4_lo(u32x4 w) { return (f32x4){bf_lo(w.x), bf_hi(w.x), bf_lo(w.y), bf_hi(w.y)}; }
__device__ __forceinline__ f32x4 bfx4_hi(u32x4 w) { return (f32x4){bf_lo(w.z), bf_hi(w.z), bf_lo(w.w), bf_hi(w.w)}; }


namespace pg8 {
constexpr int BM = 256, BK = 64, HALF = 128, HTB = HALF * BK * 2, STAGE_BYTES = 8 * HTB, NXCD = 8, WGM = 8;
__host__ __device__ __forceinline__ int lds_byte(int r, int c) { const int st = (r >> 4) * 2 + (c >> 5), rr = r & 15, cc = c & 31, ob = rr * 64 + cc * 2; return st * 1024 + (ob ^ (((ob >> 9) & 1) << 5)); }
__host__ __device__ __forceinline__ void stage_rc(int b, int& R, int& C) { const int st = b / 1024, sb = b % 1024, swz = sb ^ (((sb >> 9) & 1) << 5); R = (st >> 1) * 16 + swz / 64; C = (st & 1) * 32 + (swz % 64) / 2; }
__host__ __device__ __forceinline__ int perm32(int rho) { const int n = rho >> 4, i = rho & 15; return 8 * (i >> 2) + 4 * n + (i & 3); }

struct Unit { int pm, pn, ks; };
constexpr int KSPLIT = 8;
struct Gemm { const bf16_t* A; const bf16_t* Bt; int K; int nN_main; };

struct StaticOrder {
    int nM, nN, nwg, G, c, nsplit;
    __device__ __forceinline__ void init(int nM_, int nN_, int G_, int c_, int nsplit_ = 0) { nM = nM_; nN = nN_; nwg = nM * nN; G = G_; c = c_; nsplit = nsplit_; }
    __device__ __forceinline__ bool next(int i, Unit& u) const {
        const long L = (long)i * G + c; if (L >= nwg + nsplit * nN * KSPLIT) return false;
        int pm, pn, ks;
        if (L >= nwg) { const int e = (int)L - nwg, cu = e / KSPLIT; ks = e % KSPLIT; pm = nM + cu / nN; pn = cu % nN; }
        else {
            int wgid = (int)L; { const int q = nwg / NXCD, r = nwg % NXCD, xcd = wgid % NXCD, off = wgid / NXCD; wgid = (xcd < r ? xcd * (q + 1) : r * (q + 1) + (xcd - r) * q) + off; }
            const int nig = WGM * nN, gid = wgid / nig, fm = gid * WGM, gsz = (nM - fm) < WGM ? (nM - fm) : WGM;
            pm = fm + ((wgid % nig) % gsz); pn = (wgid % nig) / gsz; ks = -1;
        }
        u.pm = pm; u.pn = pn; u.ks = ks; return true;
    }
};

struct FuseArgs {
    unsigned char* ws; float* xoutf;
    const float* modl; const float* modn;
    const float* gpost; const float* gpre;
    int gate_off, sh_off, sc_off, cbank, write_xn, out_f32;
};
__device__ __forceinline__ void panel_rms(const f32x4 (&v)[2][2][4][2], int pm, int pn, int wr, int wc, int fr, int fq, LAS unsigned char* xl, int wid, int lane, float* slots, unsigned* cnt) {
    LAS float* P = (LAS float*)xl;
    LAS float* S = (LAS float*)(xl + 4096);
#pragma unroll
    for (int ai = 0; ai < 2; ++ai)
#pragma unroll
        for (int m = 0; m < 4; ++m) { float q = 0.f;
#pragma unroll
            for (int bj = 0; bj < 2; ++bj)
#pragma unroll
                for (int n = 0; n < 2; ++n) { const f32x4 x = v[ai][bj][m][n]; q += (x[0] * x[0] + x[1] * x[1]) + (x[2] * x[2] + x[3] * x[3]); }
            q += __shfl_xor(q, 16); q += __shfl_xor(q, 32);
            if (fq == 0) P[(ai * HALF + wr * 64 + m * 16 + fr) * 4 + wc] = q; }
    asm volatile("s_waitcnt lgkmcnt(0)" ::: "memory"); __builtin_amdgcn_s_barrier(); asm volatile("" ::: "memory");
    const int row = wid * 32 + (lane & 31);
    unsigned* sl = (unsigned*)slots + (size_t)(pm * BM + row) * 4;
    if (lane < 32) { const float f = (P[row * 4 + 0] + P[row * 4 + 1]) + (P[row * 4 + 2] + P[row * 4 + 3]);
        __hip_atomic_store(sl + pn, __float_as_uint(f), __ATOMIC_RELAXED, __HIP_MEMORY_SCOPE_AGENT); }
    asm volatile("s_waitcnt vmcnt(0)" ::: "memory");
    if (lane == 0) __hip_atomic_fetch_add(cnt + 64 * pm, 1u, __ATOMIC_RELAXED, __HIP_MEMORY_SCOPE_AGENT);
    if (wid == 0) {
        unsigned sp = 0;
        while ((unsigned)__builtin_amdgcn_readfirstlane((int)__hip_atomic_load(cnt + 64 * pm, __ATOMIC_RELAXED, __HIP_MEMORY_SCOPE_AGENT)) < 32u) { __builtin_amdgcn_s_sleep(2); if (++sp > (1u << 21)) break; }
        __builtin_amdgcn_fence(__ATOMIC_ACQUIRE, "agent");
    }
    asm volatile("s_waitcnt vmcnt(0) lgkmcnt(0)" ::: "memory"); __builtin_amdgcn_s_barrier(); asm volatile("" ::: "memory");
    if (lane < 32) { float s = 0.f;
#pragma unroll
        for (int t = 0; t < 4; ++t) s += __uint_as_float(__hip_atomic_load(sl + t, __ATOMIC_RELAXED, __HIP_MEMORY_SCOPE_AGENT));
        S[row] = rsqrtf(s * (1.f / DM) + EPS); }
    asm volatile("s_waitcnt vmcnt(0) lgkmcnt(0)" ::: "memory"); __builtin_amdgcn_s_barrier(); asm volatile("" ::: "memory");
}
__device__ __forceinline__ void fused_epi(f32x4 (&acc)[2][2][4][2], const Unit& u, int wr, int wc, int fr, int fq, LAS unsigned char* xl, int wid, int lane, const FuseArgs& f) {
    const int pm = u.pm, pn = u.pn; const size_t mrow = (size_t)(pm >> 4) * NMOD;
    const int colb = pn * BM + wc * 32 + 8 * fq;
    const LAS float* S = (const LAS float*)(xl + 4096);
    panel_rms(acc, pm, pn, wr, wc, fr, fq, xl, wid, lane, (float*)(f.ws + WS_SLOT1), (unsigned*)(f.ws + WS_CNT) + f.cbank * CNT_BANK);
    {
        f32x4 Gv[2][2];
#pragma unroll
        for (int bj = 0; bj < 2; ++bj)
#pragma unroll
            for (int n = 0; n < 2; ++n) { const int c = colb + bj * HALF + 4 * n; Gv[bj][n] = *(const f32x4*)(f.modl + f.gate_off + mrow + c) * *(const f32x4*)(f.gpost + c); }
#pragma unroll
        for (int ai = 0; ai < 2; ++ai)
#pragma unroll
            for (int m = 0; m < 4; ++m) { const int r = ai * HALF + wr * 64 + m * 16 + fr; const float rstd = S[r];
#pragma unroll
                for (int bj = 0; bj < 2; ++bj) { const size_t off = (size_t)(pm * BM + r) * DM + colb + bj * HALF;
                    const u32x4 xw = *(const u32x4*)((const bf16_t*)(f.ws + WS_XR) + off);
                    const f32x4 x0 = bfx4_lo(xw) + Gv[bj][0] * (acc[ai][bj][m][0] * rstd), x1 = bfx4_hi(xw) + Gv[bj][1] * (acc[ai][bj][m][1] * rstd);
                    if (f.out_f32) { *(f32x4*)(f.xoutf + off) = x0; *(f32x4*)(f.xoutf + off + 4) = x1; acc[ai][bj][m][0] = x0; acc[ai][bj][m][1] = x1; }
                    else { u32x4 w; w.x = cvt_pk_bf16(x0[0], x0[1]); w.y = cvt_pk_bf16(x0[2], x0[3]); w.z = cvt_pk_bf16(x1[0], x1[1]); w.w = cvt_pk_bf16(x1[2], x1[3]);
                        *(u32x4*)((bf16_t*)(f.ws + WS_XR) + off) = w; acc[ai][bj][m][0] = bfx4_lo(w); acc[ai][bj][m][1] = bfx4_hi(w); } }
                __builtin_amdgcn_sched_barrier(0); }
    }
}

template <int MODE> struct Epi {
    bf16_t* O; bf16_t* O2; float* part; FuseArgs f;
    __device__ __forceinline__ void operator()(f32x4 (&acc)[2][2][4][2], const Unit& u, int wr, int wc, int fr, int fq, LAS unsigned char* xl, int wid, int lane) const {
        int prow = u.pm, pcol = u.pn; bf16_t* base = O; size_t ldc = (MODE == 0) ? PBW : (MODE == 1 ? DM : FF);
        if (MODE == 0 && u.pn >= 6) { prow = u.pn - 6; pcol = u.pm; base = O2; ldc = VTP; }
        const int row0 = prow * BM + wr * 64 + fr, col0 = pcol * BM + wc * 32 + 8 * fq;
        if (MODE == 1 && u.ks >= 0) {
            float* pb = part + ((size_t)u.ks * MC + (size_t)(row0 - ML)) * DM + col0;
#pragma unroll
            for (int ai = 0; ai < 2; ++ai)
#pragma unroll
                for (int m = 0; m < 4; ++m) { float* rowp = pb + (size_t)(ai * HALF + m * 16) * DM;
#pragma unroll
                    for (int bj = 0; bj < 2; ++bj) { *(f32x4*)(rowp + bj * HALF) = acc[ai][bj][m][0]; *(f32x4*)(rowp + bj * HALF + 4) = acc[ai][bj][m][1]; } }
            return;
        }
        if (MODE == 1) { fused_epi(acc, u, wr, wc, fr, fq, xl, wid, lane, f); return; }
#pragma unroll
        for (int ai = 0; ai < 2; ++ai)
#pragma unroll
            for (int m = 0; m < 4; ++m) { bf16_t* rowp = base + (size_t)(row0 + ai * HALF + m * 16) * ldc + col0;
#pragma unroll
                for (int bj = 0; bj < 2; ++bj) { f32x4 v0 = acc[ai][bj][m][0], v1 = acc[ai][bj][m][1];
                    if (MODE == 2) {
#pragma unroll
                        for (int e = 0; e < 4; ++e) { const float a = fmaxf(v0[e], 0.f), b = fmaxf(v1[e], 0.f); v0[e] = a * a; v1[e] = b * b; } }
                    u32x4 w; w.x = cvt_pk_bf16(v0[0], v0[1]); w.y = cvt_pk_bf16(v0[2], v0[3]); w.z = cvt_pk_bf16(v1[0], v1[1]); w.w = cvt_pk_bf16(v1[2], v1[3]);
                    *(u32x4*)(rowp + bj * HALF) = w; } }
    }
};

template <class EpiT, bool ALIGN_EPI>
__device__ __forceinline__ void gemm_phase(LAS unsigned char* lds, const Gemm g, const StaticOrder& S, const EpiT& E, const int tid) {
    const int wid = __builtin_amdgcn_readfirstlane(tid >> 6), lane = tid & 63, wr = wid >> 2, wc = wid & 3, fr = lane & 15, fq = lane >> 4;
    const int K = g.K;
    unsigned voffA[2], voffB[2];
#pragma unroll
    for (int i = 0; i < 2; ++i) { int R, C; stage_rc(tid * 16 + i * 8192, R, C); const int Rb = (R & ~31) + perm32(R & 31);
        voffA[i] = (unsigned)(R * K + C) * 2u; voffB[i] = (unsigned)(Rb * K + C) * 2u; }
    const size_t kstep = (size_t)(BK * 2);
    const size_t hstep = (size_t)HALF * K * 2;
    const size_t tstep = 2 * hstep;
    const unsigned ldsw = (unsigned)wid * 1024u;
    const int aoff = lds_byte(wr * 64 + fr, fq * 8), boff = lds_byte(wc * 32 + fr, fq * 8);
#define PG8_SA(b, h) (((b) * 2 + (h)) * HTB)
#define PG8_SB(b, h) ((4 + (b) * 2 + (h)) * HTB)
#define PG8_STAGE(bufoff, gbase, voff) do { _Pragma("unroll") for (int _i = 0; _i < 2; ++_i) \
        __builtin_amdgcn_global_load_lds((const unsigned*)((const char*)(gbase) + (voff)[_i]), (LAS unsigned*)(lds + (bufoff) + ldsw + _i * 8192), 16, 0, 0); } while (0)
#define PG8_LDA(dst, b, h) do { _Pragma("unroll") for (int m = 0; m < 4; ++m) _Pragma("unroll") for (int k = 0; k < 2; ++k) dst[m][k] = *(const LAS bf16x8*)(lds + PG8_SA(b, h) + aoff + m * 2048 + k * 1024); } while (0)
#define PG8_LDB(dst, b, h) do { _Pragma("unroll") for (int n = 0; n < 2; ++n) _Pragma("unroll") for (int k = 0; k < 2; ++k) dst[n][k] = *(const LAS bf16x8*)(lds + PG8_SB(b, h) + boff + n * 2048 + k * 1024); } while (0)
#define PG8_MMA(ai, bj, At, Bt) do { __builtin_amdgcn_s_setprio(1); _Pragma("unroll") for (int m = 0; m < 4; ++m) _Pragma("unroll") for (int n = 0; n < 2; ++n) _Pragma("unroll") for (int k = 0; k < 2; ++k) \
        acc[ai][bj][m][n] = __builtin_amdgcn_mfma_f32_16x16x32_bf16(Bt[n][k], At[m][k], acc[ai][bj][m][n], 0, 0, 0); __builtin_amdgcn_s_setprio(0); } while (0)
#define PG8_WAIT_V(n) asm volatile("s_waitcnt vmcnt(" #n ")" ::: "memory")
#define PG8_WAIT_L(n) asm volatile("s_waitcnt lgkmcnt(" #n ")" ::: "memory")
#define PG8_BAR __builtin_amdgcn_s_barrier()
#define PG8_SCHED __builtin_amdgcn_sched_barrier(0)
#define PG8_PTRS(u, pa, pb) do { const size_t _ko = (u).ks >= 0 ? (size_t)(u).ks * (size_t)(K / KSPLIT) * 2 : 0; \
        const char* _a = (const char*)g.A + (size_t)(u).pm * tstep + _ko; const char* _b = (const char*)g.Bt + (size_t)(u).pn * tstep + _ko; \
        if ((u).pn >= g.nN_main) { pa = _b; pb = _a; } else { pa = _a; pb = _b; } } while (0)
    Unit cur, nxt; int ui = 0;
    if (!S.next(0, cur)) return;
    f32x4 acc[2][2][4][2];
#pragma unroll
    for (int a = 0; a < 2; ++a)
#pragma unroll
        for (int b = 0; b < 2; ++b)
#pragma unroll
            for (int m = 0; m < 4; ++m)
#pragma unroll
                for (int n = 0; n < 2; ++n) acc[a][b][m][n] = (f32x4){0.f, 0.f, 0.f, 0.f};
    bf16x8 At[4][2], B0[2][2], B1[2][2];
    const char* cA; const char* cB; PG8_PTRS(cur, cA, cB);
    PG8_STAGE(PG8_SB(0, 0), cB, voffB); PG8_STAGE(PG8_SB(0, 1), cB + hstep, voffB); PG8_STAGE(PG8_SA(0, 0), cA, voffA); PG8_STAGE(PG8_SA(0, 1), cA + hstep, voffA);
    if (wr == 1) PG8_BAR;
    PG8_WAIT_V(2); PG8_BAR;
    PG8_STAGE(PG8_SB(1, 0), cB + kstep, voffB); PG8_STAGE(PG8_SA(1, 0), cA + kstep, voffA); PG8_STAGE(PG8_SB(1, 1), cB + hstep + kstep, voffB);
    PG8_WAIT_V(6); PG8_BAR;
    for (;;) {
        const bool has_next = S.next(ui + 1, nxt);
        const char* nA = cA; const char* nB = cB; if (has_next) PG8_PTRS(nxt, nA, nB);
        const int nt = (cur.ks >= 0) ? (K / KSPLIT) / BK : K / BK;
        for (int t = 0; t < nt; t += 2) {
            const bool last = (t == nt - 2);
            const char* a1 = cA + (size_t)(t + 1) * kstep;
            const char* a2 = last ? nA : cA + (size_t)(t + 2) * kstep; const char* b2 = last ? nB : cB + (size_t)(t + 2) * kstep;
            const char* a3 = a2 + kstep; const char* b3 = b2 + kstep;
            PG8_LDB(B0, 0, 0); PG8_LDB(B1, 0, 1); PG8_SCHED; PG8_LDA(At, 0, 0); PG8_STAGE(PG8_SA(1, 1), a1 + hstep, voffA);
            PG8_WAIT_V(8); PG8_WAIT_L(0); PG8_BAR; PG8_MMA(0, 0, At, B0); PG8_MMA(0, 1, At, B1); PG8_BAR; PG8_SCHED;
            PG8_LDA(At, 0, 1); PG8_STAGE(PG8_SB(0, 0), b2, voffB); PG8_STAGE(PG8_SB(0, 1), b2 + hstep, voffB); PG8_STAGE(PG8_SA(0, 0), a2, voffA);
            PG8_WAIT_V(8); PG8_WAIT_L(0); PG8_BAR; PG8_MMA(1, 0, At, B0); PG8_MMA(1, 1, At, B1); PG8_BAR; PG8_SCHED;
            PG8_LDB(B0, 1, 0); PG8_LDB(B1, 1, 1); PG8_SCHED; PG8_LDA(At, 1, 0); PG8_STAGE(PG8_SA(0, 1), a2 + hstep, voffA);
            PG8_WAIT_V(8); PG8_WAIT_L(0); PG8_BAR; PG8_MMA(0, 0, At, B0); PG8_MMA(0, 1, At, B1); PG8_BAR; PG8_SCHED;
            PG8_LDA(At, 1, 1); PG8_STAGE(PG8_SB(1, 0), b3, voffB); PG8_STAGE(PG8_SB(1, 1), b3 + hstep, voffB); PG8_STAGE(PG8_SA(1, 0), a3, voffA);
            PG8_WAIT_V(8); PG8_WAIT_L(0); PG8_BAR; PG8_MMA(1, 0, At, B0); PG8_MMA(1, 1, At, B1); PG8_BAR; PG8_SCHED;
        }
        if constexpr (ALIGN_EPI) { if (wr == 0) PG8_BAR; }
        E(acc, cur, wr, wc, fr, fq, lds + STAGE_BYTES, wid, lane);
        if (!has_next) break;
#pragma unroll
        for (int a = 0; a < 2; ++a)
#pragma unroll
            for (int b = 0; b < 2; ++b)
#pragma unroll
                for (int m = 0; m < 4; ++m)
#pragma unroll
                    for (int n = 0; n < 2; ++n) acc[a][b][m][n] = (f32x4){0.f, 0.f, 0.f, 0.f};
        cur = nxt; cA = nA; cB = nB; ++ui;
        if constexpr (ALIGN_EPI) { if (wr == 1) PG8_BAR; }
    }
    PG8_WAIT_V(0);
    if constexpr (!ALIGN_EPI) { if (wr == 0) PG8_BAR; }
    PG8_BAR;
#undef PG8_SA
#undef PG8_SB
#undef PG8_STAGE
#undef PG8_LDA
#undef PG8_LDB
#undef PG8_MMA
#undef PG8_WAIT_V
#undef PG8_WAIT_L
#undef PG8_BAR
#undef PG8_SCHED
#undef PG8_PTRS
}
}

#define XB_TMO      128
#define XB_XCNT(j)  (256  + 64 * (j))
#define XB_XSUB(j)  (1280 + 64 * (j))
#define XB_XGEN(j)  (2304 + 64 * (j))
#define XB_TOP      3328
#define XB_TOPGEN   3392
#define XCD_BAR_WORDS 3456
#define XB_SPIN_CAP (1u << 18)
__device__ __forceinline__ unsigned xb_ld(unsigned* p)              { return __hip_atomic_load(p, __ATOMIC_RELAXED, __HIP_MEMORY_SCOPE_AGENT); }
__device__ __forceinline__ unsigned xb_add(unsigned* p, unsigned v) { return __hip_atomic_fetch_add(p, v, __ATOMIC_RELAXED, __HIP_MEMORY_SCOPE_AGENT); }
__device__ __forceinline__ unsigned xb_xcc_id() { return (unsigned)__builtin_amdgcn_s_getreg((3 << 11) | 20) & 0xFu; }
#define XB_SPIN(cond, bar) do { unsigned _sp = 0; while (cond) { __builtin_amdgcn_s_sleep(1); \
    if ((++_sp & 255u) == 0u) { if (xb_ld(&(bar)[XB_TMO])) break; if (_sp > XB_SPIN_CAP) { atomicAdd(&(bar)[XB_TMO], 1u); break; } } } } while (0)
struct XcdBarrier { unsigned* bar; unsigned x; volatile LAS unsigned* st; };
__device__ __forceinline__ XcdBarrier xcd_barrier_post(unsigned* bar, volatile LAS unsigned* st) {
    XcdBarrier b; b.bar = bar; b.x = xb_xcc_id(); b.st = st;
    if (threadIdx.x == 0) (void)xb_add(&bar[XB_XCNT(b.x)], 1u);
    return b;
}
__device__ __forceinline__ void xcd_barrier_complete(unsigned* bar, unsigned x, unsigned& nloc, unsigned& nx) {
    const unsigned G = gridDim.x * gridDim.y * gridDim.z;
    unsigned sum, cnt, mine, sp = 0u;
    for (;;) {
        sum = 0u; cnt = 0u; mine = 0u;
#pragma unroll
        for (unsigned j = 0; j < 16; ++j) { const unsigned c = xb_ld(&bar[XB_XCNT(j)]); sum += c; cnt += (c > 0u) ? 1u : 0u; mine = (j == x) ? c : mine; }
        if (sum == G) break;
        __builtin_amdgcn_s_sleep(1);
        if ((++sp & 255u) == 0u) { if (xb_ld(&bar[XB_TMO])) break; if (sp > XB_SPIN_CAP) { atomicAdd(&bar[XB_TMO], 1u); break; } }
    }
    nloc = mine > 0u ? mine : 1u; nx = cnt > 0u ? cnt : 1u;
}
__device__ __forceinline__ void xcd_barrier(const XcdBarrier& b) {
    asm volatile("s_waitcnt vmcnt(0)" ::: "memory");
    __syncthreads();
    if (threadIdx.x == 0) {
        unsigned* bar = b.bar;
        __builtin_amdgcn_s_waitcnt(0);
        unsigned nloc = b.st[0], nx = b.st[1];
        if (nloc == 0u) { xcd_barrier_complete(bar, b.x, nloc, nx); b.st[0] = nloc; b.st[1] = nx; }
        const unsigned old = xb_add(&bar[XB_XSUB(b.x)], 1u);
        const unsigned gen = old / nloc;
        if (old + 1u == (gen + 1u) * nloc) {
            __builtin_amdgcn_fence(__ATOMIC_RELEASE, "agent");
            asm volatile("s_waitcnt vmcnt(0)" ::: "memory");
            const unsigned og = xb_add(&bar[XB_TOP], 1u);
            const unsigned tg = og / nx;
            if (og + 1u == (tg + 1u) * nx) xb_add(&bar[XB_TOPGEN], 1u);
            else XB_SPIN(xb_ld(&bar[XB_TOPGEN]) == tg, bar);
            __builtin_amdgcn_fence(__ATOMIC_ACQUIRE, "agent");
            xb_add(&bar[XB_XGEN(b.x)], 1u);
            asm volatile("s_waitcnt vmcnt(0)" ::: "memory");
        } else {
            XB_SPIN(xb_ld(&bar[XB_XGEN(b.x)]) == gen, bar);
            __builtin_amdgcn_fence(__ATOMIC_ACQUIRE, "agent");
            asm volatile("s_waitcnt vmcnt(0)" ::: "memory");
        }
    }
    __syncthreads();
}

struct Params {
    const float* in[17];
    float* out; unsigned char* ws;
    int ph_lo, ph_hi;
};
enum { I_X = 0, I_C, I_CTX, I_CCTX, I_WMOD, I_BMOD, I_GPREMIX, I_GPOSTMIX, I_GPREMLP, I_GPOSTMLP, I_WIN, I_POOLW, I_POOLS, I_RPB, I_WOUT, I_W1, I_W2 };

__device__ __forceinline__ void transpose_item(const float* W, int ldw, bf16_t* WT, int ldt, int kofs, int nblk, LAS float* scr, int item, int lane) {
    const int kb = item / nblk, nb = item % nblk, k0 = 64 * kb, n0 = 32 * nb;
#pragma unroll 8
    for (int i = 0; i < 32; ++i) { const int kk = 2 * i + (lane >> 5); scr[kk * 33 + (lane & 31)] = W[(size_t)(k0 + kk) * ldw + n0 + (lane & 31)]; }
    LDS_WAIT(); asm volatile("" ::: "memory");
    const int c = lane & 7;
#pragma unroll
    for (int j = 0; j < 4; ++j) { const int n = (lane >> 3) + 8 * j; const LAS float* s = scr + (8 * c) * 33 + n;
        u32x4 o; o.x = cvt_pk_bf16(s[0 * 33], s[1 * 33]); o.y = cvt_pk_bf16(s[2 * 33], s[3 * 33]); o.z = cvt_pk_bf16(s[4 * 33], s[5 * 33]); o.w = cvt_pk_bf16(s[6 * 33], s[7 * 33]);
        *(u32x4*)(WT + (size_t)(n0 + n) * ldt + kofs + k0 + 8 * c) = o; }
    LDS_WAIT(); asm volatile("" ::: "memory");
}

__device__ __forceinline__ float silu_f(float v) { return v / (1.f + __expf(-v)); }

__device__ __forceinline__ void mod_item(const Params& p, LAS unsigned char* lds, int item, int tid, int wave, int lane) {
    LAS float* sv = (LAS float*)lds;
    LAS float* part = (LAS float*)(lds + 36864);
    const int l = item / 24, j0 = (item % 24) * 256;
    for (int i = tid; i < 9 * 1024; i += NTHR) { const int r = i >> 10, k = i & 1023; const float v = (r < 8) ? p.in[I_C][r * 1024 + k] : p.in[I_CCTX][k]; sv[i] = silu_f(v); }
    __syncthreads();
    f32x4 acc[9];
#pragma unroll
    for (int r = 0; r < 9; ++r) acc[r] = (f32x4){0.f, 0.f, 0.f, 0.f};
    const float* wp = p.in[I_WMOD] + (size_t)l * DM * NMOD + (size_t)(wave * 128) * NMOD + j0 + 4 * lane;
#pragma unroll 1
    for (int k8 = 0; k8 < 128; k8 += 8) {
        f32x4 wv[8];
#pragma unroll
        for (int u = 0; u < 8; ++u) wv[u] = *(const f32x4*)(wp + (size_t)(k8 + u) * NMOD);
#pragma unroll
        for (int u = 0; u < 8; ++u)
#pragma unroll
            for (int r = 0; r < 9; ++r) { const float s = sv[r * 1024 + wave * 128 + k8 + u]; acc[r] += wv[u] * s; }
    }
#pragma unroll
    for (int r = 0; r < 9; ++r) *(LAS f32x4*)(part + (wave * 9 + r) * 256 + 4 * lane) = acc[r];
    __syncthreads();
    float* mod = (float*)(p.ws + WS_MOD) + (size_t)l * 9 * NMOD;
    for (int i = tid; i < 9 * 256; i += NTHR) { const int r = i >> 8, j = i & 255; float s = p.in[I_BMOD][l * NMOD + j0 + j];
#pragma unroll
        for (int w = 0; w < 8; ++w) s += part[(w * 9 + r) * 256 + j];
        mod[r * NMOD + j0 + j] = s; }
    __syncthreads();
}

__device__ __forceinline__ void weff_item(const Params& p, LAS unsigned char* lds, int item, int tid, int wave, int lane) {
    LAS float* pw = (LAS float*)lds;
    LAS float* wo = (LAS float*)(lds + 128 * 129 * 4);
    const int l = item >> 6, g = (item >> 4) & 3, n0 = (item & 15) * 64;
    const float* pwg = p.in[I_POOLW] + ((size_t)l * 4 + g) * 128 * 128;
    for (int i = tid; i < 128 * 128; i += NTHR) pw[(i >> 7) * 129 + (i & 127)] = pwg[i];
    const float* wog = p.in[I_WOUT] + (size_t)l * DM * DM + (size_t)(g * 128) * DM + n0;
    const float* psg = p.in[I_POOLS] + l * 512 + g * 128;
    for (int i = tid; i < 128 * 64; i += NTHR) { const int d = i >> 6, n = i & 63; wo[i] = wog[(size_t)d * DM + n] * psg[d]; }
    __syncthreads();
    float acc[16];
#pragma unroll
    for (int c = 0; c < 16; ++c) acc[c] = 0.f;
    const int n = lane, cb = wave * 16;
#pragma unroll 4
    for (int d = 0; d < 128; ++d) { const float w = wo[d * 64 + n];
#pragma unroll
        for (int c = 0; c < 16; ++c) acc[c] += pw[(cb + c) * 129 + d] * w; }
    bf16_t* dst = (bf16_t*)(p.ws + WS_WOUT) + (size_t)l * DM * DM + (size_t)(n0 + n) * DM + g * 128 + cb;
    u32x4 o0, o1;
    o0.x = cvt_pk_bf16(acc[0], acc[1]); o0.y = cvt_pk_bf16(acc[2], acc[3]); o0.z = cvt_pk_bf16(acc[4], acc[5]); o0.w = cvt_pk_bf16(acc[6], acc[7]);
    o1.x = cvt_pk_bf16(acc[8], acc[9]); o1.y = cvt_pk_bf16(acc[10], acc[11]); o1.z = cvt_pk_bf16(acc[12], acc[13]); o1.w = cvt_pk_bf16(acc[14], acc[15]);
    *(u32x4*)dst = o0; *(u32x4*)(dst + 8) = o1;
    __syncthreads();
}

__device__ __forceinline__ void phase_prologue(const Params& p, LAS unsigned char* lds, int G, int tid, int wave, int lane) {
    for (int it = blockIdx.x; it < DEPTH * 24; it += G) mod_item(p, lds, it, tid, wave, lane);
    for (int it = blockIdx.x; it < DEPTH * 64; it += G) weff_item(p, lds, it, tid, wave, lane);
    LAS float* scr = (LAS float*)(lds + wave * 16384);
    const int gw = blockIdx.x * NWAVES + wave, NGW = G * NWAVES;
    constexpr int I_IN = 16 * 64, I_O = 8 * 32, I_1 = 16 * 128, I_2 = 64 * 32, I_L = I_IN + I_O + I_1 + I_2;
    for (int it = gw; it < DEPTH * I_L; it += NGW) {
        const int l = it / I_L; int r = it % I_L;
        if (r < I_IN) { transpose_item(p.in[I_WIN] + (size_t)l * DM * NIN, NIN, (bf16_t*)(p.ws + WS_WIN) + (size_t)l * NIN * DM, DM, 0, NIN / 32, scr, r, lane); continue; } r -= I_IN;
        if (r < I_O) { transpose_item(p.in[I_WOUT] + (size_t)l * DM * DM + (size_t)512 * DM, DM, (bf16_t*)(p.ws + WS_WOUT) + (size_t)l * DM * DM, DM, 512, DM / 32, scr, r, lane); continue; } r -= I_O;
        if (r < I_1) { transpose_item(p.in[I_W1] + (size_t)l * DM * FF, FF, (bf16_t*)(p.ws + WS_W1) + (size_t)l * FF * DM, DM, 0, FF / 32, scr, r, lane); continue; } r -= I_1;
        transpose_item(p.in[I_W2] + (size_t)l * FF * DM, DM, (bf16_t*)(p.ws + WS_W2) + (size_t)l * DM * FF, FF, 0, DM / 32, scr, r, lane);
    }
}

struct RowArgs {
    const void* xlat; const void* xctx; bool xin_f32;
    void* olat; void* octx; bool xout_f32;
    const float* gpost; const float* mod_cur;
    int gate_off;
    const float* gpre; const float* mod_nxt; int sh_off, sc_off;
    int nrows; bool has_y, write_xn, ctx_split, ctx_only, copy_x, lat_no_y;
};
__device__ __forceinline__ void phase_rows(const Params& p, const RowArgs& a, int G, int wave, int lane) {
    bf16_t* XN = (bf16_t*)(p.ws + WS_XN);
    const int gw = blockIdx.x * NWAVES + wave, NGW = G * NWAVES;
    f32x4 gpo[4], gpr[4];
#pragma unroll
    for (int j = 0; j < 4; ++j) { const int c = 8 * lane + 512 * (j >> 1) + 4 * (j & 1);
        gpo[j] = a.has_y ? *(const f32x4*)(a.gpost + c) : (f32x4){0.f, 0.f, 0.f, 0.f};
        gpr[j] = a.write_xn ? *(const f32x4*)(a.gpre + c) : (f32x4){0.f, 0.f, 0.f, 0.f}; }
    const int wpb = NGW / NB;
    const bool bmaj = (NGW % NB == 0) && ((SEQ / 2) % wpb == 0);
    const int ppw = bmaj ? (SEQ / 2) / wpb : 0;
    const int nit = bmaj ? ppw + ((a.nrows > ML) ? ((a.nrows - ML) / 2 + NGW - 1) / NGW : 0) : (a.nrows / 2 + NGW - 1) / NGW;
    int cur_rb = -1;
    f32x4 gt[4], sh[4], sc[4];
#pragma unroll 1
    for (int it = (a.ctx_only && bmaj) ? ppw : 0; it < nit; ++it) {
        int mp;
        if (bmaj) mp = (it < ppw) ? (gw / wpb) * (SEQ / 2) + (gw % wpb) + it * wpb : ML / 2 + gw + (it - ppw) * NGW;
        else mp = ((a.ctx_only && !bmaj) ? ML / 2 : 0) + gw + it * NGW;
        if (mp >= a.nrows / 2) break;
        const int m0 = 2 * mp; const bool isl = m0 < ML; const int rb = isl ? (m0 >> 12) : 8;
        const bool use_y = a.has_y && !(a.lat_no_y && isl);
        const size_t xoff = isl ? (size_t)m0 * DM : (size_t)(m0 - ML) * DM;
        const void* xrb = isl ? a.xlat : a.xctx; void* xob = isl ? a.olat : a.octx;
        bf16_t* xn = XN + (size_t)m0 * DM;
        const size_t moff = (size_t)rb * NMOD;
        f32x4 v[2][4], y[2][4];
        if (a.xin_f32) {
#pragma unroll
            for (int u = 0; u < 2; ++u)
#pragma unroll
                for (int j = 0; j < 4; ++j) v[u][j] = *(const f32x4*)((const float*)xrb + xoff + u * DM + 8 * lane + 512 * (j >> 1) + 4 * (j & 1));
        } else {
#pragma unroll
            for (int u = 0; u < 2; ++u)
#pragma unroll
                for (int jb = 0; jb < 2; ++jb) { const u32x4 xw = *(const u32x4*)((const bf16_t*)xrb + xoff + u * DM + 8 * lane + 512 * jb); v[u][2 * jb] = bfx4_lo(xw); v[u][2 * jb + 1] = bfx4_hi(xw); }
        }
        if (use_y) {
            if (isl || !a.ctx_split) {
#pragma unroll
                for (int u = 0; u < 2; ++u)
#pragma unroll
                    for (int jb = 0; jb < 2; ++jb) { const u32x4 yw = *(const u32x4*)(xn + u * DM + 8 * lane + 512 * jb); y[u][2 * jb] = bfx4_lo(yw); y[u][2 * jb + 1] = bfx4_hi(yw); }
            } else {
                const float* part = (const float*)p.out;
#pragma unroll
                for (int u = 0; u < 2; ++u)
#pragma unroll
                    for (int j = 0; j < 4; ++j) { const float* pp = part + (size_t)(m0 + u - ML) * DM + 8 * lane + 512 * (j >> 1) + 4 * (j & 1); f32x4 s = *(const f32x4*)pp;
#pragma unroll
                        for (int k = 1; k < pg8::KSPLIT; ++k) s += *(const f32x4*)(pp + (size_t)k * MC * DM);
                        y[u][j] = s; }
            }
        }
        if (rb != cur_rb) {
            cur_rb = rb;
            if (use_y) {
#pragma unroll
                for (int j = 0; j < 4; ++j) gt[j] = *(const f32x4*)(a.mod_cur + moff + a.gate_off + 8 * lane + 512 * (j >> 1) + 4 * (j & 1));
            }
            if (a.write_xn) {
#pragma unroll
                for (int j = 0; j < 4; ++j) { const int c = 8 * lane + 512 * (j >> 1) + 4 * (j & 1); sh[j] = *(const f32x4*)(a.mod_nxt + moff + a.sh_off + c); sc[j] = *(const f32x4*)(a.mod_nxt + moff + a.sc_off + c); }
            }
        }
        __builtin_amdgcn_sched_barrier(0);
        if (a.copy_x) {
#pragma unroll
            for (int u = 0; u < 2; ++u)
#pragma unroll
                for (int jb = 0; jb < 2; ++jb) { u32x4 w; w.x = cvt_pk_bf16(v[u][2 * jb][0], v[u][2 * jb][1]); w.y = cvt_pk_bf16(v[u][2 * jb][2], v[u][2 * jb][3]);
                    w.z = cvt_pk_bf16(v[u][2 * jb + 1][0], v[u][2 * jb + 1][1]); w.w = cvt_pk_bf16(v[u][2 * jb + 1][2], v[u][2 * jb + 1][3]);
                    *(u32x4*)((bf16_t*)xob + xoff + u * DM + 8 * lane + 512 * jb) = w; v[u][2 * jb] = bfx4_lo(w); v[u][2 * jb + 1] = bfx4_hi(w); }
        }
        if (use_y) {
#pragma unroll
            for (int u = 0; u < 2; ++u) {
                float s = 0.f;
#pragma unroll
                for (int j = 0; j < 4; ++j) s += (y[u][j][0] * y[u][j][0] + y[u][j][1] * y[u][j][1]) + (y[u][j][2] * y[u][j][2] + y[u][j][3] * y[u][j][3]);
                const float rstd = rsqrtf(wave_sum(s) * (1.f / DM) + EPS);
#pragma unroll
                for (int j = 0; j < 4; ++j) v[u][j] = v[u][j] + gt[j] * (y[u][j] * rstd * gpo[j]);
                if (a.xout_f32) {
#pragma unroll
                    for (int j = 0; j < 4; ++j) *(f32x4*)((float*)xob + xoff + u * DM + 8 * lane + 512 * (j >> 1) + 4 * (j & 1)) = v[u][j];
                } else {
#pragma unroll
                    for (int jb = 0; jb < 2; ++jb) { u32x4 w; w.x = cvt_pk_bf16(v[u][2 * jb][0], v[u][2 * jb][1]); w.y = cvt_pk_bf16(v[u][2 * jb][2], v[u][2 * jb][3]);
                        w.z = cvt_pk_bf16(v[u][2 * jb + 1][0], v[u][2 * jb + 1][1]); w.w = cvt_pk_bf16(v[u][2 * jb + 1][2], v[u][2 * jb + 1][3]);
                        *(u32x4*)((bf16_t*)xob + xoff + u * DM + 8 * lane + 512 * jb) = w; v[u][2 * jb] = bfx4_lo(w); v[u][2 * jb + 1] = bfx4_hi(w); }
                } }
        }
        if (a.write_xn) {
#pragma unroll
            for (int u = 0; u < 2; ++u) {
                float s2 = 0.f;
#pragma unroll
                for (int j = 0; j < 4; ++j) s2 += (v[u][j][0] * v[u][j][0] + v[u][j][1] * v[u][j][1]) + (v[u][j][2] * v[u][j][2] + v[u][j][3] * v[u][j][3]);
                const float rstd = rsqrtf(wave_sum(s2) * (1.f / DM) + EPS);
#pragma unroll
                for (int jb = 0; jb < 2; ++jb) { const f32x4 h0 = (v[u][2 * jb] * rstd * gpr[2 * jb]) * (sc[2 * jb] + 1.f) + sh[2 * jb], h1 = (v[u][2 * jb + 1] * rstd * gpr[2 * jb + 1]) * (sc[2 * jb + 1] + 1.f) + sh[2 * jb + 1];
                    u32x4 w; w.x = cvt_pk_bf16(h0[0], h0[1]); w.y = cvt_pk_bf16(h0[2], h0[3]); w.z = cvt_pk_bf16(h1[0], h1[1]); w.w = cvt_pk_bf16(h1[2], h1[3]);
                    *(u32x4*)(xn + u * DM + 8 * lane + 512 * jb) = w; } }
        }
    }
}

constexpr float LOG2E = 1.4426950408889634f;
constexpr int RPB_PITCH = 64, RPB_OFF = 16;

constexpr int AT_KC = 0, AT_VC = 32768;
constexpr int AT_KL = 0, AT_VL = 73728, AT_VLP = 1280, AT_RPB = AT_VL + 64 * AT_VLP;
static_assert(AT_RPB + 15 * 64 * 4 <= LDS_BYTES - 16, "attention LDS map");
__device__ __forceinline__ int kswz(int key) { return ((key >> 1) & 1) | (((key >> 3) & 3) << 1); }

template <bool LOC>
__device__ __forceinline__ void attn_half(const LAS unsigned char* lds, int kaddr0, int kaddr1, int kcs, int vrow, int vchunk0, int vcs, int vpitch_dt,
                                          const LAS float* bp, int elo, const bf16x8 q0, const bf16x8 q1, float& mx, float& lsum, f32x4 (&o)[4], int g, int qi) {
    constexpr float SC = 0.125f * LOG2E;
    float s[8][8];
    bf16x8 kf[2][4];
#define AH_LDK(c, bufi) do { kf[bufi][0] = *(const LAS bf16x8*)(lds + kaddr0 + (c) * kcs); kf[bufi][1] = *(const LAS bf16x8*)(lds + kaddr1 + (c) * kcs); \
        kf[bufi][2] = *(const LAS bf16x8*)(lds + kaddr0 + (c) * kcs + 512); kf[bufi][3] = *(const LAS bf16x8*)(lds + kaddr1 + (c) * kcs + 512); } while (0)
    AH_LDK(0, 0);
#pragma unroll
    for (int c = 0; c < 8; ++c) {
        if (c < 7) AH_LDK(c + 1, (c + 1) & 1);
        __builtin_amdgcn_sched_barrier(0);
        f32x4 t0 = (f32x4){0.f, 0.f, 0.f, 0.f}, t1 = (f32x4){0.f, 0.f, 0.f, 0.f};
        t0 = __builtin_amdgcn_mfma_f32_16x16x32_bf16(kf[c & 1][0], q0, t0, 0, 0, 0); t1 = __builtin_amdgcn_mfma_f32_16x16x32_bf16(kf[c & 1][2], q0, t1, 0, 0, 0);
        t0 = __builtin_amdgcn_mfma_f32_16x16x32_bf16(kf[c & 1][1], q1, t0, 0, 0, 0); t1 = __builtin_amdgcn_mfma_f32_16x16x32_bf16(kf[c & 1][3], q1, t1, 0, 0, 0);
#pragma unroll
        for (int e = 0; e < 8; ++e) { const float a = (e < 4) ? t0[e] : t1[e - 4];
            if (LOC) { const float bv = bp[c * RPB_PITCH + e]; const bool ok = (e >= elo) && (e < elo + 16); s[c][e] = ok ? (a * SC + bv) : -INFINITY; }
            else s[c][e] = a * SC; }
        __builtin_amdgcn_sched_barrier(0);
    }
#undef AH_LDK
    float m2 = mx;
#pragma unroll
    for (int c = 0; c < 8; ++c)
#pragma unroll
        for (int e = 0; e < 8; ++e) m2 = fmaxf(m2, s[c][e]);
    m2 = fmaxf(m2, __shfl_xor(m2, 16)); m2 = fmaxf(m2, __shfl_xor(m2, 32));
    const float alpha = __builtin_amdgcn_exp2f(mx - m2);
    mx = m2; lsum *= alpha;
#pragma unroll
    for (int dt = 0; dt < 4; ++dt) o[dt] = o[dt] * alpha;
    bf16x8 vf[2][4];
#define AH_LDV(c, bufi) do { const int vaddr = vrow + (((vchunk0 + (c) * vcs + g) ^ qi) << 4); _Pragma("unroll") for (int dt = 0; dt < 4; ++dt) vf[bufi][dt] = *(const LAS bf16x8*)(lds + vaddr + dt * vpitch_dt); } while (0)
    AH_LDV(0, 0);
#pragma unroll
    for (int c = 0; c < 8; ++c) {
        if (c < 7) AH_LDV(c + 1, (c + 1) & 1);
        __builtin_amdgcn_sched_barrier(0);
        float pe[8];
#pragma unroll
        for (int e = 0; e < 8; ++e) { pe[e] = __builtin_amdgcn_exp2f(s[c][e] - mx); lsum += pe[e]; }
        u32x4 pw; pw.x = cvt_pk_bf16(pe[0], pe[1]); pw.y = cvt_pk_bf16(pe[2], pe[3]); pw.z = cvt_pk_bf16(pe[4], pe[5]); pw.w = cvt_pk_bf16(pe[6], pe[7]);
        const bf16x8 pb = __builtin_bit_cast(bf16x8, pw);
#pragma unroll
        for (int dt = 0; dt < 4; ++dt) o[dt] = __builtin_amdgcn_mfma_f32_16x16x32_bf16(vf[c & 1][dt], pb, o[dt], 0, 0, 0);
        __builtin_amdgcn_sched_barrier(0);
    }
#undef AH_LDV
}

__device__ __forceinline__ void attn_store(bf16_t* MIX, int qtok, int h, int g, float lsum, const f32x4 (&o)[4]) {
    lsum += __shfl_xor(lsum, 16); lsum += __shfl_xor(lsum, 32);
    const float inv = 1.f / lsum;
    bf16_t* op = MIX + (size_t)qtok * DM + 512 + h * 64 + 4 * g;
#pragma unroll
    for (int dt = 0; dt < 4; ++dt) { u32x2 w; w.x = cvt_pk_bf16(o[dt][0] * inv, o[dt][1] * inv); w.y = cvt_pk_bf16(o[dt][2] * inv, o[dt][3] * inv); *(u32x2*)(op + 16 * dt) = w; }
}

__device__ __forceinline__ void phase_mixer(const Params& p, LAS unsigned char* lds, int l, bool with_ctx, int G, int tid, int wave, int lane, int rep_attn, int rep_pool) {
    const bf16_t* PB = (const bf16_t*)(p.ws + WS_PB); const bf16_t* VT = (const bf16_t*)(p.ws + WS_VT); bf16_t* MIX = (bf16_t*)(p.ws + WS_MIX);
    const int gw = blockIdx.x * NWAVES + wave, NGW = G * NWAVES;
    const int qi = lane & 15, g = lane >> 4, kap = 8 * (qi >> 2) + (qi & 3);
#pragma unroll 1
    for (int ra = 0; ra < rep_attn; ++ra)
#pragma unroll 1
    for (int I = blockIdx.x; I < 64 * 32; I += G) {
        const int x = I & 7, t = I >> 3, j = t & 31, rho = t >> 5, pr = rho * 8 + x, b = pr >> 3, h = pr & 7;
        const int r0 = 2 * j, rs0 = min(max(r0 - 4, 0), 56);
        const int r = r0 + (wave >> 2), n = wave & 3, rs = min(max(r - 4, 0), 56), kc0 = min(max(16 * n - 8, 0), 32);
        const int qc = 16 * n + qi, qs = min(max(qc - 8, 0), 48);
        const int sel = (j - 2 * rho) & 31;
        const int npass = (with_ctx && sel < 2) ? 2 : 1;
        {
            u32x4 kreg[4], vreg[4];
            const bf16_t* ksrc = PB + (size_t)(ML + b * CT + (tid >> 3)) * PBW + 1024 + h * 64 + (tid & 7) * 8;
            const bf16_t* vsrc = VT + (size_t)(h * 64 + (tid >> 5)) * VTP + ML + b * CT + (tid & 31) * 8;
#pragma unroll
            for (int ps = 0; ps < 4; ++ps) { kreg[ps] = *(const u32x4*)(ksrc + (size_t)(ps * 64) * PBW); vreg[ps] = *(const u32x4*)(vsrc + (size_t)(ps * 16) * VTP); }
            __builtin_amdgcn_sched_barrier(0);
#pragma unroll
            for (int ps = 0; ps < 4; ++ps) { const int key = ps * 64 + (tid >> 3), d = ps * 16 + (tid >> 5);
                *(LAS u32x4*)(lds + AT_KC + key * 128 + ((((tid & 7) ^ kswz(key))) << 4)) = kreg[ps];
                *(LAS u32x4*)(lds + AT_VC + d * 512 + ((((tid & 31) ^ (d & 15))) << 4)) = vreg[ps]; }
        }
        __syncthreads();
        float mxA = -INFINITY, lA = 0.f; f32x4 oA[4]; bf16x8 qA0, qA1;
        {
            const int kl = kap, ka0 = AT_KC + kl * 128 + ((g ^ kswz(kl)) << 4), ka1 = AT_KC + kl * 128 + (((g + 4) ^ kswz(kl)) << 4);
            const int vrow = AT_VC + qi * 512;
#pragma unroll 1
            for (int ps = 2 - npass; ps < 2; ++ps) {
                const int qtok = (ps == 1) ? (b * SEQ + r * 64 + 16 * n + qi) : (ML + b * CT + 16 * (sel * 8 + wave) + qi);
                const bf16_t* qp = PB + (size_t)qtok * PBW + 512 + h * 64 + 8 * g;
                qA0 = *(const bf16x8*)qp; qA1 = *(const bf16x8*)(qp + 32);
                mxA = -INFINITY; lA = 0.f;
#pragma unroll
                for (int dt = 0; dt < 4; ++dt) oA[dt] = (f32x4){0.f, 0.f, 0.f, 0.f};
                attn_half<false>(lds, ka0, ka1, 32 * 128, vrow, 0, 4, 16 * 512, nullptr, 0, qA0, qA1, mxA, lA, oA, g, qi);
                if (ps == 0) attn_store(MIX, qtok, h, g, lA, oA);
            }
        }
        __syncthreads();
        {
            const int tok0 = b * SEQ + rs0 * 64;
            const bf16_t* ksrc = PB + (size_t)(tok0 + (tid >> 3)) * PBW + 1024 + h * 64 + (tid & 7) * 8;
            u32x4 kreg[9], vreg[9];
#pragma unroll
            for (int ps = 0; ps < 9; ++ps) { const int idx = ps * 512 + tid, d = idx / 72, ch = idx - d * 72;
                kreg[ps] = *(const u32x4*)(ksrc + (size_t)(ps * 64) * PBW);
                vreg[ps] = *(const u32x4*)(VT + (size_t)(h * 64 + d) * VTP + tok0 + ch * 8); }
            __builtin_amdgcn_sched_barrier(0);
#pragma unroll
            for (int ps = 0; ps < 9; ++ps) { const int key = ps * 64 + (tid >> 3), idx = ps * 512 + tid, d = idx / 72, ch = idx - d * 72;
                *(LAS u32x4*)(lds + AT_KL + key * 128 + ((((tid & 7) ^ kswz(key))) << 4)) = kreg[ps];
                *(LAS u32x4*)(lds + AT_VL + d * AT_VLP + ((ch ^ (d & 15)) << 4)) = vreg[ps]; }
            LAS float* rp = (LAS float*)(lds + AT_RPB);
            for (int i = tid; i < 15 * RPB_PITCH; i += NTHR) { const int row = i >> 6, cc = (i & 63) - RPB_OFF; rp[i] = (cc >= 0 && cc < 31) ? p.in[I_RPB][(size_t)(l * 8 + h) * 15 * 31 + row * 31 + cc] * LOG2E : 0.f; }
        }
        __syncthreads();
        {
            const int kl = (rs - rs0) * 64 + kc0 + kap, ka0 = AT_KL + kl * 128 + ((g ^ kswz(kl)) << 4), ka1 = AT_KL + kl * 128 + (((g + 4) ^ kswz(kl)) << 4);
            const int vrow = AT_VL + qi * AT_VLP, vch0 = (rs - rs0) * 8 + (kc0 >> 3);
            const LAS float* bp = (const LAS float*)(lds + AT_RPB) + (rs - r + 7) * RPB_PITCH + RPB_OFF + (kc0 + 8 * g - qc + 15);
            attn_half<true>(lds, ka0, ka1, 64 * 128, vrow, vch0, 8, 16 * AT_VLP, bp, qs - kc0 - 8 * g, qA0, qA1, mxA, lA, oA, g, qi);
            attn_store(MIX, b * SEQ + r * 64 + 16 * n + qi, h, g, lA, oA);
        }
        __syncthreads();
    }
    const int nrun = (with_ctx ? MT : ML) / 16;
    const int grp = lane >> 4, lo = 1 << grp, hi = lo - 1;
#pragma unroll 1
    for (int rp = 0; rp < rep_pool; ++rp)
#pragma unroll 1
    for (int run = gw; run < nrun; run += NGW) {
        const int tok0 = run * 16; const bool isl = tok0 < ML;
        const int base = isl ? (tok0 & ~(SEQ - 1)) : (ML + ((tok0 - ML) & ~(CT - 1))), len = isl ? SEQ : CT, t0 = tok0 - base;
        u32x4 w[31];
#pragma unroll
        for (int i = 0; i < 31; ++i) { const int tt = min(max(t0 - 8 + i, 0), len - 1); w[i] = *(const u32x4*)(PB + (size_t)(base + tt) * PBW + 8 * lane); }
#pragma unroll
        for (int o = 0; o < 16; ++o) {
            const int t = t0 + o, st = max(t - lo, 0), en = min(t + hi + 1, len);
            float acc[8];
#pragma unroll
            for (int e = 0; e < 8; ++e) acc[e] = 0.f;
#pragma unroll
            for (int i = 0; i < 16; ++i) { const int tt = t + i - 8; const float wt = (tt >= st && tt < en) ? 1.f : 0.f; const u32x4 ww = w[o + i];
                acc[0] += wt * bf_lo(ww.x); acc[1] += wt * bf_hi(ww.x); acc[2] += wt * bf_lo(ww.y); acc[3] += wt * bf_hi(ww.y);
                acc[4] += wt * bf_lo(ww.z); acc[5] += wt * bf_hi(ww.z); acc[6] += wt * bf_lo(ww.w); acc[7] += wt * bf_hi(ww.w); }
            const float ic = 1.f / (float)(en - st);
            const u32x4 sw = w[o + 8];
            u32x4 ov; ov.x = cvt_pk_bf16(acc[0] * ic - bf_lo(sw.x), acc[1] * ic - bf_hi(sw.x)); ov.y = cvt_pk_bf16(acc[2] * ic - bf_lo(sw.y), acc[3] * ic - bf_hi(sw.y));
            ov.z = cvt_pk_bf16(acc[4] * ic - bf_lo(sw.z), acc[5] * ic - bf_hi(sw.z)); ov.w = cvt_pk_bf16(acc[6] * ic - bf_lo(sw.w), acc[7] * ic - bf_hi(sw.w));
            *(u32x4*)(MIX + (size_t)(tok0 + o) * DM + 8 * lane) = ov;
        }
    }
    __syncthreads();
}

constexpr int NPHASE = 2 + 7 * DEPTH;
__global__ void __launch_bounds__(NTHR) fwd_kernel(Params p) {
    extern __shared__ __attribute__((aligned(16))) unsigned char lds_raw[];
    LAS unsigned char* lds = (LAS unsigned char*)lds_raw;
    const int G = gridDim.x;
    const int ph_hi = p.ph_hi;
    volatile LAS unsigned* xst = (volatile LAS unsigned*)(lds + LDS_BYTES - 16);
    if (threadIdx.x < 4) xst[threadIdx.x] = 0u;
    unsigned* const xbar = (unsigned*)(p.ws + WS_BAR);
    if (blockIdx.x == 0) for (int i = threadIdx.x; i < XCD_BAR_WORDS; i += NTHR) __hip_atomic_store(&xbar[i], 0u, __ATOMIC_RELAXED, __HIP_MEMORY_SCOPE_AGENT);
    __syncthreads();
    XcdBarrier xb; xb.bar = xbar; xb.x = 0; xb.st = xst;
    bool xb_posted = false;
    for (int ph = p.ph_lo; ph < ph_hi; ++ph) {
#if PROBE_DUP
        int ptype = -1; if (ph == 0) ptype = 0; else if (ph >= 2) { const int s_ = (ph - 2) % 7; ptype = (s_ == 0) ? 2 : (s_ == 1) ? 1 : (s_ == 2) ? 3 : (s_ == 4) ? 4 : (s_ == 5) ? 5 : -1; }
        const int nrep = (ptype >= 0 && ((PROBE_DUP >> ptype) & 1)) ? 2 : 1;
        for (int rep = 0; rep < nrep; ++rep) {
        if (rep) __syncthreads();
#endif
        int z = 0; asm volatile("s_mov_b32 %0, 0" : "=s"(z));
        Params q;
#pragma unroll
        for (int i = 0; i < 17; ++i) q.in[i] = p.in[i] + z;
        q.out = p.out + z; q.ws = p.ws + z; q.ph_lo = 0; q.ph_hi = 0;
        const int tid = threadIdx.x + z, lane = tid & 63, wave = __builtin_amdgcn_readfirstlane(tid >> 6);
        const float* mod = (const float*)(q.ws + WS_MOD);
        bf16_t* XN = (bf16_t*)(q.ws + WS_XN);
        bf16_t* ctxr = (bf16_t*)(q.ws + WS_CTXR); bf16_t* xres = (bf16_t*)(q.ws + WS_XR);
        if (ph == 0) {
            for (int i = blockIdx.x * NTHR + tid; i < 16 * CNT_BANK; i += G * NTHR) __hip_atomic_store((unsigned*)(q.ws + WS_CNT) + i, 0u, __ATOMIC_RELAXED, __HIP_MEMORY_SCOPE_AGENT);
            phase_prologue(q, lds, G, tid, wave, lane);
        }
        else if (ph == 1) {
            RowArgs a{}; a.xlat = q.in[I_X]; a.xctx = q.in[I_CTX]; a.xin_f32 = true; a.nrows = MT; a.has_y = false; a.write_xn = true; a.copy_x = true; a.olat = xres; a.octx = ctxr;
            a.gpre = q.in[I_GPREMIX]; a.mod_nxt = mod; a.sh_off = 0; a.sc_off = DM;
            phase_rows(q, a, G, wave, lane);
        } else {
            const int l = (ph - 2) / 7, s = (ph - 2) % 7; const bool last = (l == DEPTH - 1);
            const int nMrows = last ? ML / 256 : MT / 256;
            if (s == 0) {
                pg8::Gemm g{XN, (const bf16_t*)(q.ws + WS_WIN) + (size_t)l * NIN * DM, DM, 6};
                pg8::StaticOrder S; S.init(MT / 256, 8, G, (int)blockIdx.x);
                pg8::Epi<0> E{(bf16_t*)(q.ws + WS_PB), (bf16_t*)(q.ws + WS_VT), nullptr};
                pg8::gemm_phase<pg8::Epi<0>, true>(lds, g, S, E, tid);
            } else if (s == 1) {
                phase_mixer(q, lds, l, !last, G, tid, wave, lane, 1 + ((PROBE_DUP >> 8) & 1), 1 + ((PROBE_DUP >> 6) & 1));
            } else if (s == 2) {
                pg8::Gemm g{(const bf16_t*)(q.ws + WS_MIX), (const bf16_t*)(q.ws + WS_WOUT) + (size_t)l * DM * DM, DM, 1 << 30};
                pg8::StaticOrder S; S.init(ML / 256, 4, G, (int)blockIdx.x, last ? 0 : MC / 256);
                pg8::FuseArgs fa{}; fa.ws = q.ws; fa.modl = mod + (size_t)l * 9 * NMOD; fa.modn = fa.modl; fa.gpost = q.in[I_GPOSTMIX] + l * DM; fa.gpre = q.in[I_GPREMLP] + l * DM;
                fa.gate_off = 2 * DM; fa.sh_off = 3 * DM; fa.sc_off = 4 * DM; fa.cbank = l * 4; fa.write_xn = 1; fa.out_f32 = 0;
                pg8::Epi<1> E{XN, nullptr, q.out, fa};
                pg8::gemm_phase<pg8::Epi<1>, true>(lds, g, S, E, tid);
            } else if (s == 3) {
                RowArgs a{}; a.xlat = xres; a.xctx = ctxr; a.xin_f32 = false; a.olat = xres; a.octx = ctxr; a.xout_f32 = false;
                a.gpost = q.in[I_GPOSTMIX] + l * DM; a.mod_cur = mod + (size_t)l * 9 * NMOD; a.gate_off = 2 * DM;
                a.gpre = q.in[I_GPREMLP] + l * DM; a.mod_nxt = a.mod_cur; a.sh_off = 3 * DM; a.sc_off = 4 * DM;
                a.nrows = nMrows * 256; a.has_y = true; a.write_xn = true; a.ctx_split = true; a.lat_no_y = true;
                phase_rows(q, a, G, wave, lane);
            } else if (s == 4) {
                pg8::Gemm g{XN, (const bf16_t*)(q.ws + WS_W1) + (size_t)l * FF * DM, DM, 1 << 30};
                pg8::StaticOrder S; S.init(nMrows, 16, G, (int)blockIdx.x);
                pg8::Epi<2> E{(bf16_t*)(q.ws + WS_H), nullptr, nullptr};
                pg8::gemm_phase<pg8::Epi<2>, true>(lds, g, S, E, tid);
            } else if (s == 5) {
                pg8::Gemm g{(const bf16_t*)(q.ws + WS_H), (const bf16_t*)(q.ws + WS_W2) + (size_t)l * DM * FF, FF, 1 << 30};
                pg8::StaticOrder S; S.init(ML / 256, 4, G, (int)blockIdx.x, last ? 0 : MC / 256);
                pg8::FuseArgs fa{}; fa.ws = q.ws; fa.xoutf = q.out; fa.modl = mod + (size_t)l * 9 * NMOD; fa.modn = mod + (size_t)(last ? l : l + 1) * 9 * NMOD; fa.gpost = q.in[I_GPOSTMLP] + l * DM; fa.gpre = q.in[I_GPREMIX] + (last ? l : l + 1) * DM;
                fa.gate_off = 5 * DM; fa.sh_off = 0; fa.sc_off = DM; fa.cbank = l * 4 + 2; fa.write_xn = last ? 0 : 1; fa.out_f32 = last ? 1 : 0;
                pg8::Epi<1> E{XN, nullptr, q.out, fa};
                pg8::gemm_phase<pg8::Epi<1>, true>(lds, g, S, E, tid);
            } else {
                RowArgs a{}; a.xlat = xres; a.xctx = ctxr; a.xin_f32 = false; a.olat = last ? (void*)q.out : (void*)xres; a.octx = ctxr; a.xout_f32 = last;
                a.gpost = q.in[I_GPOSTMLP] + l * DM; a.mod_cur = mod + (size_t)l * 9 * NMOD; a.gate_off = 5 * DM;
                a.nrows = nMrows * 256; a.has_y = true; a.write_xn = !last; a.ctx_split = true;
                if (!last) { a.gpre = q.in[I_GPREMIX] + (l + 1) * DM; a.mod_nxt = mod + (size_t)(l + 1) * 9 * NMOD; a.sh_off = 0; a.sc_off = DM; }
                a.lat_no_y = true;
                if (!last) phase_rows(q, a, G, wave, lane);
            }
        }
#if PROBE_DUP
        }
#endif
        if (ph + 1 < ph_hi) {
            if (!xb_posted) { cg::this_grid().sync(); xb = xcd_barrier_post(xbar, xst); xb_posted = true; }
            else { xcd_barrier(xb); if (PROBE_DUP & 128) xcd_barrier(xb); }
        }
    }
}

extern "C" void kernel_launch(void* const* d_in, const int* in_sizes, int n_in, void* d_out, int out_size, void* d_ws, size_t ws_size, hipStream_t stream) {
    static int grid = 0;
    if (grid == 0) {
        if (n_in != 17 || in_sizes[0] != ML * DM || out_size != ML * DM || ws_size < WS_END) { fprintf(stderr, "kernel_launch: unexpected shapes (n_in %d, in0 %d, out %d, ws %zu)\n", n_in, n_in > 0 ? in_sizes[0] : -1, out_size, ws_size); grid = -1; return; }
        int dev = 0, cus = 0, per_cu = 0;
        (void)hipGetDevice(&dev);
        (void)hipDeviceGetAttribute(&cus, hipDeviceAttributeMultiprocessorCount, dev);
        if (hipFuncSetAttribute((const void*)fwd_kernel, hipFuncAttributeMaxDynamicSharedMemorySize, LDS_BYTES) != hipSuccess) { fprintf(stderr, "kernel_launch: hipFuncSetAttribute failed\n"); grid = -1; return; }
        if (hipOccupancyMaxActiveBlocksPerMultiprocessor(&per_cu, (const void*)fwd_kernel, NTHR, LDS_BYTES) != hipSuccess || per_cu < 1) { fprintf(stderr, "kernel_launch: occupancy query says %d\n", per_cu); per_cu = 1; }
        (void)hipGetLastError();
        grid = cus * 1;
    }
    if (grid < 0) return;
    Params p{};
    for (int i = 0; i < 17; ++i) p.in[i] = (const float*)d_in[i];
    p.out = (float*)d_out; p.ws = (unsigned char*)d_ws;
#if MK_SPLIT
    for (int ph = 0; ph < NPHASE; ++ph) { p.ph_lo = ph; p.ph_hi = ph + 1; hipLaunchKernelGGL(fwd_kernel, dim3(grid), dim3(NTHR), LDS_BYTES, stream, p); }
#else
    p.ph_lo = 0; p.ph_hi = NPHASE;
    void* args[] = {&p};
    hipError_t e = hipLaunchCooperativeKernel((const void*)fwd_kernel, dim3(grid), dim3(NTHR), args, LDS_BYTES, stream);
    if (e != hipSuccess) fprintf(stderr, "cooperative launch failed: %s (grid %d)\n", hipGetErrorString(e), grid);
#endif
}
```
